# Optimizing an MI355X kernel written in HIP

```python
import jax, jax.numpy as jnp
from jax import lax
import numpy as np

D_MODEL = 2048
BATCH = 4
SEQ = 2048
DEPTH = 4

N_MIXERS = 3
N_A = (DEPTH + 2) // 3
N_B = (DEPTH + 1) // 3
N_C = DEPTH // 3

HEAD_DIM = 128
N_HEADS = D_MODEL // HEAD_DIM

GRID_W = 64
NA_KH_MAX = 8
NA_KW = 16

DIL_GROUPS = ((128, 1), (512, 4), (2048, 16))
N_DIL = len(DIL_GROUPS)
DSW_QBLOCK = 128

MLA_Q_RANK = 512
MLA_KV_RANK = 512
MLA_NOPE = 128
MLA_ROPE = 64
MLA_V = 128
MLA_QBLOCK = 128

D_FF = 4 * D_MODEL

ROPE_THETA = 10000.0
EPS = 1e-6
NEG = -1e30

kernel_name = "hybrid_na_dilated_mla_encoder"


def rms_norm(x, g):
    xf = x.astype(jnp.float32)
    y = xf * lax.rsqrt(jnp.mean(xf * xf, axis=-1, keepdims=True) + EPS)
    return (y * g.astype(jnp.float32)).astype(x.dtype)


def rope(x, pos):
    dr = x.shape[-1]
    inv = 1.0 / (ROPE_THETA ** (jnp.arange(0, dr, 2, dtype=jnp.float32) / dr))
    ang = pos.astype(jnp.float32)[:, None] * inv[None, :]
    cos = jnp.cos(ang)[None, :, None, :]
    sin = jnp.sin(ang)[None, :, None, :]
    xf = x.astype(jnp.float32)
    x1, x2 = xf[..., : dr // 2], xf[..., dr // 2:]
    out = jnp.concatenate([x1 * cos - x2 * sin, x2 * cos + x1 * sin], axis=-1)
    return out.astype(x.dtype)


def neighborhood_attention(x, w_qkv, w_o, rpb):
    B, S, _ = x.shape
    rows = S // GRID_W
    kh = min(NA_KH_MAX, rows)
    ncb = GRID_W // NA_KW
    kbw = 2 * NA_KW
    qkv = (x @ w_qkv).reshape(B, rows, GRID_W, 3, N_HEADS, HEAD_DIM)
    q, k, v = qkv[:, :, :, 0], qkv[:, :, :, 1], qkv[:, :, :, 2]

    cb = np.arange(ncb)
    col_start = np.clip(cb * NA_KW - NA_KW // 2, 0, GRID_W - kbw)
    key_cols = col_start[:, None] + np.arange(kbw)[None, :]
    q_cols = cb[:, None] * NA_KW + np.arange(NA_KW)[None, :]
    win_start = np.clip(q_cols - NA_KW // 2, 0, GRID_W - NA_KW)
    kc = key_cols[:, None, :]
    col_valid = (kc >= win_start[..., None]) & (kc < win_start[..., None] + NA_KW)
    dc_idx = np.clip(kc - q_cols[..., None] + NA_KW - 1, 0, 2 * NA_KW - 2)
    bias_cols = rpb.astype(jnp.float32)[:, :, dc_idx] + jnp.asarray(
        np.where(col_valid, 0.0, NEG), jnp.float32)[None, None]

    scale = HEAD_DIM ** -0.5
    q_rows = q.reshape(B, rows, ncb, NA_KW, N_HEADS, HEAD_DIM).transpose(1, 0, 2, 3, 4, 5)

    def row_fn(args):
        qr, r = args
        r0 = jnp.clip(r - kh // 2, 0, rows - kh)
        kr = lax.dynamic_slice_in_dim(k, r0, kh, axis=1)[:, :, key_cols]
        vr = lax.dynamic_slice_in_dim(v, r0, kh, axis=1)[:, :, key_cols]
        dr = r0 + jnp.arange(kh) - r + NA_KH_MAX - 1
        bias = jnp.take(bias_cols, dr, axis=1).transpose(0, 2, 3, 1, 4)
        s = jnp.einsum('bnqhd,bankhd->bhnqak', qr, kr).astype(jnp.float32) * scale + bias
        shp = s.shape
        p = jax.nn.softmax(s.reshape(shp[:4] + (kh * kbw,)), axis=-1).reshape(shp)
        return jnp.einsum('bhnqak,bankhd->bnqhd', p.astype(vr.dtype), vr)

    o = lax.map(row_fn, (q_rows, jnp.arange(rows)))
    o = o.transpose(1, 0, 2, 3, 4, 5).reshape(B, S, N_HEADS * HEAD_DIM)
    return o @ w_o


def _dilated_band(q, k, v, dil, half):
    B, S, H, dh = q.shape
    L = S // dil
    nblk = -(-L // DSW_QBLOCK)
    Lp = nblk * DSW_QBLOCK
    kb = DSW_QBLOCK + 2 * half
    res = lambda t: t.reshape(B, L, dil, H, dh)
    qr = jnp.pad(res(q), ((0, 0), (0, Lp - L), (0, 0), (0, 0), (0, 0)))
    qr = qr.reshape(B, nblk, DSW_QBLOCK, dil, H, dh)
    pad_kv = ((0, 0), (half, Lp - L + half), (0, 0), (0, 0), (0, 0))
    idx = np.arange(nblk)[:, None] * DSW_QBLOCK + np.arange(kb)[None, :]
    kg = jnp.pad(res(k), pad_kv)[:, idx]
    vg = jnp.pad(res(v), pad_kv)[:, idx]
    qq = np.arange(DSW_QBLOCK)
    kk = np.arange(kb)
    rel = kk[None, :] - half - qq[:, None]
    mk = idx - half
    valid = (np.abs(rel)[None] <= half) & ((mk >= 0) & (mk < L))[:, None, :]
    s = jnp.einsum('bnqrhd,bnkrhd->bhrnqk', qr, kg).astype(jnp.float32) * (dh ** -0.5)
    s = jnp.where(valid, s, NEG)
    mx = jnp.max(s, axis=-1, keepdims=True)
    p = jnp.exp(s - mx)
    l = jnp.sum(p, axis=-1, keepdims=True)
    o = jnp.einsum('bhrnqk,bnkrhd->bnqrhd', (p / l).astype(vg.dtype), vg)
    lse = (mx + jnp.log(l))[..., 0]
    o = o.reshape(B, Lp, dil, H, dh)[:, :L].reshape(B, S, H, dh)
    lse = lse.transpose(0, 3, 4, 2, 1).reshape(B, Lp, dil, H)[:, :L].reshape(B, S, H)
    return o, lse


def dilated_window_attention(x, w_qkv, w_o):
    B, S, _ = x.shape
    pos = jnp.arange(S)
    qkv = (x @ w_qkv).reshape(B, S, N_DIL, 3, N_HEADS, HEAD_DIM)
    outs, lses = [], []
    for g, (window, dil) in enumerate(DIL_GROUPS):
        qg = rope(qkv[:, :, g, 0], pos)
        kg = rope(qkv[:, :, g, 1], pos)
        og, lg = _dilated_band(qg, kg, qkv[:, :, g, 2], dil, window // (2 * dil))
        outs.append(og)
        lses.append(lg)
    wts = jax.nn.softmax(jnp.stack(lses, axis=0), axis=0)
    o = jnp.einsum('gbsh,gbshd->bshd', wts.astype(outs[0].dtype), jnp.stack(outs, axis=0))
    return o.reshape(B, S, N_HEADS * HEAD_DIM) @ w_o


def mla_attention(x, w_in, q_norm, kv_norm, w_uq, w_ukv, w_o):
    B, S, _ = x.shape
    pos = jnp.arange(S)
    hcat = x @ w_in
    cq = rms_norm(hcat[..., :MLA_Q_RANK], q_norm)
    ckv = rms_norm(hcat[..., MLA_Q_RANK:MLA_Q_RANK + MLA_KV_RANK], kv_norm)
    k_rope = hcat[..., MLA_Q_RANK + MLA_KV_RANK:]
    q = (cq @ w_uq).reshape(B, S, N_HEADS, MLA_NOPE + MLA_ROPE)
    kv = (ckv @ w_ukv).reshape(B, S, N_HEADS, MLA_NOPE + MLA_V)
    q = jnp.concatenate([q[..., :MLA_NOPE], rope(q[..., MLA_NOPE:], pos)], axis=-1)
    k_r = jnp.broadcast_to(rope(k_rope[:, :, None, :], pos), (B, S, N_HEADS, MLA_ROPE))
    k = jnp.concatenate([kv[..., :MLA_NOPE], k_r], axis=-1)
    v = kv[..., MLA_NOPE:]
    scale = (MLA_NOPE + MLA_ROPE) ** -0.5
    nq = S // MLA_QBLOCK
    qb = q.reshape(B, nq, MLA_QBLOCK, N_HEADS, MLA_NOPE + MLA_ROPE).transpose(1, 0, 2, 3, 4)

    def block_fn(qi):
        s = jnp.einsum('bqhd,bkhd->bhqk', qi, k).astype(jnp.float32) * scale
        p = jax.nn.softmax(s, axis=-1)
        return jnp.einsum('bhqk,bkhd->bqhd', p.astype(v.dtype), v)

    o = lax.map(block_fn, qb)
    o = o.transpose(1, 0, 2, 3, 4).reshape(B, S, N_HEADS * MLA_V)
    return o @ w_o


def squared_relu_mlp(x, w_up, w_down):
    return jnp.square(jax.nn.relu(x @ w_up)) @ w_down


def setup_inputs(seed: int = 0) -> dict:
    key = jax.random.key(seed)
    ks = jax.random.split(key, 24)
    f32 = jnp.float32

    def w(k, shape, fan_in, mult=1.0):
        return jax.random.normal(k, shape, f32) * (mult * fan_in ** -0.5)

    def gain(k, shape):
        return 1.0 + 0.1 * jax.random.normal(k, shape, f32)

    D = D_MODEL
    HD = N_HEADS * HEAD_DIM
    return {
        "x": jax.random.normal(ks[0], (BATCH, SEQ, D), f32),
        "c": jax.random.normal(ks[1], (BATCH, D), f32),
        "norm1": gain(ks[2], (DEPTH, D)),
        "norm2": gain(ks[3], (DEPTH, D)),
        "w_mod": w(ks[4], (DEPTH, D, 6 * D), D, 0.5),
        "b_mod": 0.01 * jax.random.normal(ks[5], (DEPTH, 6 * D), f32),
        "na_w_qkv": w(ks[6], (N_A, D, 3 * HD), D),
        "na_w_o": w(ks[7], (N_A, HD, D), HD),
        "na_rpb": 0.1 * jax.random.normal(ks[8], (N_A, N_HEADS, 2 * NA_KH_MAX - 1, 2 * NA_KW - 1), f32),
        "dsw_w_qkv": w(ks[9], (N_B, D, N_DIL * 3 * HD), D),
        "dsw_w_o": w(ks[10], (N_B, HD, D), HD),
        "mla_w_in": w(ks[11], (N_C, D, MLA_Q_RANK + MLA_KV_RANK + MLA_ROPE), D),
        "mla_q_norm": gain(ks[12], (N_C, MLA_Q_RANK)),
        "mla_kv_norm": gain(ks[13], (N_C, MLA_KV_RANK)),
        "mla_w_uq": w(ks[14], (N_C, MLA_Q_RANK, N_HEADS * (MLA_NOPE + MLA_ROPE)), MLA_Q_RANK),
        "mla_w_ukv": w(ks[15], (N_C, MLA_KV_RANK, N_HEADS * (MLA_NOPE + MLA_V)), MLA_KV_RANK),
        "mla_w_o": w(ks[16], (N_C, N_HEADS * MLA_V, D), N_HEADS * MLA_V),
        "w_up": w(ks[17], (DEPTH, D, D_FF), D),
        "w_down": w(ks[18], (DEPTH, D_FF, D), D_FF),
        "final_norm": gain(ks[19], (D,)),
    }


def reference(x, c, norm1, norm2, w_mod, b_mod, na_w_qkv, na_w_o, na_rpb, dsw_w_qkv, dsw_w_o,
              mla_w_in, mla_q_norm, mla_kv_norm, mla_w_uq, mla_w_ukv, mla_w_o,
              w_up, w_down, final_norm):
    mod_all = jnp.einsum('bd,ldm->lbm', jax.nn.silu(c), w_mod) + b_mod[:, None, :]
    h = x
    for i in range(DEPTH):
        shift_t, scale_t, gate_t, shift_m, scale_m, gate_m = jnp.split(mod_all[i][:, None, :], 6, axis=-1)
        u = rms_norm(h, norm1[i]) * (1.0 + scale_t) + shift_t
        kind, slot = i % N_MIXERS, i // N_MIXERS
        if kind == 0:
            y = neighborhood_attention(u, na_w_qkv[slot], na_w_o[slot], na_rpb[slot])
        elif kind == 1:
            y = dilated_window_attention(u, dsw_w_qkv[slot], dsw_w_o[slot])
        else:
            y = mla_attention(u, mla_w_in[slot], mla_q_norm[slot], mla_kv_norm[slot],
                              mla_w_uq[slot], mla_w_ukv[slot], mla_w_o[slot])
        h = h + gate_t * y
        u = rms_norm(h, norm2[i]) * (1.0 + scale_m) + shift_m
        h = h + gate_m * squared_relu_mlp(u, w_up[i], w_down[i])
    return rms_norm(h, final_norm)
```

```cpp
#include <hip/hip_runtime.h>
#include <cstdio>
#include <cstdint>

#ifndef PHMASK
#define PHMASK 0xFFFFFFFFu
#endif
#define PH_EN(k) (((PHMASK) >> (k)) & 1u)
#ifndef MK_N_LAUNCHES
#define MK_N_LAUNCHES 1
#endif

namespace pg8 {
#define PG8_LAS __attribute__((address_space(3)))
typedef unsigned short bf16_t;
typedef short bf16x8 __attribute__((ext_vector_type(8)));
typedef float f32x4 __attribute__((ext_vector_type(4)));
typedef unsigned u32x4 __attribute__((ext_vector_type(4)));
constexpr int BM = 256, BK = 64, HALF = 128, HTB = HALF * BK * 2  , STAGE_BYTES = 8 * HTB, NXCD = 8, WGM = 8;

__host__ __device__ __forceinline__ int lds_byte(int r, int c) { const int st = (r >> 4) * 2 + (c >> 5), rr = r & 15, cc = c & 31, ob = rr * 64 + cc * 2; return st * 1024 + (ob ^ (((ob >> 9) & 1) << 5)); }
__host__ __device__ __forceinline__ void stage_rc(int b, int& R, int& C) { const int st = b / 1024, sb = b % 1024, swz = sb ^ (((sb >> 9) & 1) << 5); R = (st >> 1) * 16 + swz / 64; C = (st & 1) * 32 + (swz % 64) / 2; }
__host__ __device__ __forceinline__ int perm32(int rho) { const int n = rho >> 4, i = rho & 15; return 8 * (i >> 2) + 4 * n + (i & 3); }

struct Unit { int pm, pn; };
struct Gemm { const bf16_t* A; const bf16_t* Bt; int M, N, K; };

struct StaticOrder {
    int nM, nN, nwg, G, c;
    __host__ __device__ void init(int M, int N, int G_, int c_) { nM = M / BM; nN = N / BM; nwg = nM * nN; G = G_; c = c_; }
    __host__ __device__ bool next(int i, Unit& u) const {
        const long L = (long)i * G + c; if (L >= nwg) return false;
        int wgid = (int)L; { const int q = nwg / NXCD, r = nwg % NXCD, xcd = wgid % NXCD, off = wgid / NXCD; wgid = (xcd < r ? xcd * (q + 1) : r * (q + 1) + (xcd - r) * q) + off; }
        const int nig = WGM * nN, gid = wgid / nig, fm = gid * WGM, gsz = (nM - fm) < WGM ? (nM - fm) : WGM;
        u.pm = fm + ((wgid % nig) % gsz); u.pn = (wgid % nig) / gsz; return true;
    }
    __device__ __forceinline__ void a_ready(const Unit&) const {}
    __device__ __forceinline__ void done(const Unit&) const {}
};

__device__ __forceinline__ unsigned cvt_pk_bf16(float lo, float hi) { unsigned r; asm volatile("v_cvt_pk_bf16_f32 %0, %1, %2" : "=v"(r) : "v"(lo), "v"(hi)); return r; }

template <int ACT  > struct EpiBf16 {
    static constexpr bool PERM = true, AFTER_DRAIN = false;
    bf16_t* O; int ldc;
    __device__ __forceinline__ void operator()(const f32x4 (&acc)[2][2][4][2], const Unit& u, int wr, int wc, int fr, int fq) const {
        const int row0 = u.pm * BM + wr * 64 + fr; const int col0 = u.pn * BM + wc * 32 + 8 * fq;
#pragma unroll
        for (int ai = 0; ai < 2; ++ai)
#pragma unroll
            for (int m = 0; m < 4; ++m) { bf16_t* rowp = O + (size_t)(row0 + ai * HALF + m * 16) * ldc + col0;
#pragma unroll
                for (int bj = 0; bj < 2; ++bj) { f32x4 v0 = acc[ai][bj][m][0], v1 = acc[ai][bj][m][1];
                    if (ACT == 1) {
#pragma unroll
                        for (int j = 0; j < 4; ++j) { const float a = fmaxf(v0[j], 0.f), b = fmaxf(v1[j], 0.f); v0[j] = a * a; v1[j] = b * b; } }
                    u32x4 w; w.x = cvt_pk_bf16(v0[0], v0[1]); w.y = cvt_pk_bf16(v0[2], v0[3]); w.z = cvt_pk_bf16(v1[0], v1[1]); w.w = cvt_pk_bf16(v1[2], v1[3]);
                    *(u32x4*)(rowp + bj * HALF) = w; } }
    }
};
struct EpiF32 {
    static constexpr bool PERM = false, AFTER_DRAIN = false;
    float* C; int ldc;
    __device__ __forceinline__ void operator()(const f32x4 (&acc)[2][2][4][2], const Unit& u, int wr, int wc, int fr, int fq) const {
        const int row0 = u.pm * BM + wr * 64 + fr, col0 = u.pn * BM + wc * 32 + 4 * fq;
#pragma unroll
        for (int ai = 0; ai < 2; ++ai)
#pragma unroll
            for (int m = 0; m < 4; ++m) { float* rowp = C + (size_t)(row0 + ai * HALF + m * 16) * ldc + col0;
#pragma unroll
                for (int bj = 0; bj < 2; ++bj)
#pragma unroll
                    for (int n = 0; n < 2; ++n) *(f32x4*)(rowp + bj * HALF + n * 16) = acc[ai][bj][m][n]; }
    }
};
struct EpiGateRes {
    static constexpr bool PERM = false, AFTER_DRAIN = false;
    const float* base; float* out; int ldc; const float* gate; int gate_bstride;
    __device__ __forceinline__ void operator()(const f32x4 (&acc)[2][2][4][2], const Unit& u, int wr, int wc, int fr, int fq) const {
        const int row0 = u.pm * BM + wr * 64 + fr, col0 = u.pn * BM + wc * 32 + 4 * fq;
        const float* g = gate + (size_t)(u.pm >> 3) * gate_bstride + col0;
        f32x4 gv[2][2];
#pragma unroll
        for (int bj = 0; bj < 2; ++bj)
#pragma unroll
            for (int n = 0; n < 2; ++n) gv[bj][n] = *(const f32x4*)(g + bj * HALF + n * 16);
#pragma unroll
        for (int ai = 0; ai < 2; ++ai)
#pragma unroll
            for (int m = 0; m < 4; ++m) { const size_t off = (size_t)(row0 + ai * HALF + m * 16) * ldc + col0;
#pragma unroll
                for (int bj = 0; bj < 2; ++bj)
#pragma unroll
                    for (int n = 0; n < 2; ++n) { const f32x4 bs = *(const f32x4*)(base + off + bj * HALF + n * 16);
                        *(f32x4*)(out + off + bj * HALF + n * 16) = bs + gv[bj][n] * acc[ai][bj][m][n]; }
                asm volatile("" ::: "memory"); }
    }
};

template <class Epi, class Sched, bool ALIGN_EPI = false, bool SP2 = false>
__device__ __forceinline__ void gemm_phase(PG8_LAS unsigned char* lds, const Gemm g, const Sched& S, const Epi& E) {
    int tid_ = threadIdx.x; asm volatile("" : "+v"(tid_));
    const int tid = tid_, wid = __builtin_amdgcn_readfirstlane(tid >> 6), lane = tid & 63, wr = wid >> 2, wc = wid & 3, fr = lane & 15, fq = lane >> 4;
    const int K = g.K, nt = K / BK;
    unsigned voffA[2], voffB[2];
#pragma unroll
    for (int i = 0; i < 2; ++i) { int R, C; stage_rc(tid * 16 + i * 8192, R, C); const int Rb = Epi::PERM ? ((R & ~31) + perm32(R & 31)) : R;
        voffA[i] = (unsigned)(R * K + C) * 2u; voffB[i] = (unsigned)(Rb * K + C) * 2u; }
    const size_t kstep = (size_t)(BK * 2);
    const size_t hstep = (size_t)HALF * K * 2;
    const size_t tstep = 2 * hstep;
    const unsigned ldsw = (unsigned)wid * 1024u;
    const int aoff = lds_byte(wr * 64 + fr, fq * 8), boff = lds_byte(wc * 32 + fr, fq * 8);
#define PG8_SA(b, h) (((b) * 2 + (h)) * HTB)
#define PG8_SB(b, h) ((4 + (b) * 2 + (h)) * HTB)
#define PG8_STAGE(bufoff, gbase, voff) do { _Pragma("unroll") for (int _i = 0; _i < 2; ++_i) \
        __builtin_amdgcn_global_load_lds((const unsigned*)((const char*)(gbase) + (voff)[_i]), (PG8_LAS unsigned*)(lds + (bufoff) + ldsw + _i * 8192), 16, 0, 0); } while (0)
#define PG8_LDA(dst, b, h) do { _Pragma("unroll") for (int m = 0; m < 4; ++m) _Pragma("unroll") for (int k = 0; k < 2; ++k) dst[m][k] = *(const PG8_LAS bf16x8*)(lds + PG8_SA(b, h) + aoff + m * 2048 + k * 1024); } while (0)
#define PG8_LDB(dst, b, h) do { _Pragma("unroll") for (int n = 0; n < 2; ++n) _Pragma("unroll") for (int k = 0; k < 2; ++k) dst[n][k] = *(const PG8_LAS bf16x8*)(lds + PG8_SB(b, h) + boff + n * 2048 + k * 1024); } while (0)
#define PG8_MMA(ai, bj, At, Bt) do { __builtin_amdgcn_s_setprio(1); _Pragma("unroll") for (int m = 0; m < 4; ++m) _Pragma("unroll") for (int n = 0; n < 2; ++n) _Pragma("unroll") for (int k = 0; k < 2; ++k) \
        acc[ai][bj][m][n] = __builtin_amdgcn_mfma_f32_16x16x32_bf16(Bt[n][k], At[m][k], acc[ai][bj][m][n], 0, 0, 0); __builtin_amdgcn_s_setprio(0); } while (0)
#define PG8_WAIT_V(n) asm volatile("s_waitcnt vmcnt(" #n ")" ::: "memory")
#define PG8_WAIT_L(n) asm volatile("s_waitcnt lgkmcnt(" #n ")" ::: "memory")
#define PG8_BAR __builtin_amdgcn_s_barrier()
#define PG8_SCHED __builtin_amdgcn_sched_barrier(0)
    Unit cur, nxt; int ui = 0;
    if (!S.next(0, cur)) return;
    f32x4 acc[2][2][4][2];
    float zf = 0.f; asm volatile("" : "+v"(zf));
#pragma unroll
    for (int a = 0; a < 2; ++a)
#pragma unroll
        for (int b = 0; b < 2; ++b)
#pragma unroll
            for (int m = 0; m < 4; ++m)
#pragma unroll
                for (int n = 0; n < 2; ++n) acc[a][b][m][n] = (f32x4){zf, zf, zf, zf};
    bf16x8 At[4][2], B0[2][2], B1[2][2];
    const char* cA = (const char*)g.A + (size_t)cur.pm * tstep; const char* cB = (const char*)g.Bt + (size_t)cur.pn * tstep;
    S.a_ready(cur);
    if constexpr (SP2) {
        PG8_STAGE(PG8_SB(0, 0), cB, voffB); PG8_STAGE(PG8_SB(0, 1), cB + hstep, voffB); PG8_STAGE(PG8_SA(0, 0), cA, voffA); PG8_STAGE(PG8_SA(0, 1), cA + hstep, voffA);
        if (wr == 1) PG8_BAR;
        PG8_WAIT_V(2); PG8_BAR;
        PG8_STAGE(PG8_SB(1, 0), cB + kstep, voffB); PG8_STAGE(PG8_SA(1, 0), cA + kstep, voffA); PG8_STAGE(PG8_SB(1, 1), cB + hstep + kstep, voffB);
        PG8_WAIT_V(6); PG8_BAR;
    } else {
        PG8_STAGE(PG8_SB(0, 0), cB, voffB); PG8_STAGE(PG8_SA(0, 0), cA, voffA); PG8_STAGE(PG8_SB(0, 1), cB + hstep, voffB); PG8_STAGE(PG8_SA(0, 1), cA + hstep, voffA);
        if (wr == 1) PG8_BAR;
        PG8_WAIT_V(4); PG8_BAR;
        PG8_STAGE(PG8_SB(1, 0), cB + kstep, voffB); PG8_STAGE(PG8_SA(1, 0), cA + kstep, voffA); PG8_STAGE(PG8_SB(1, 1), cB + hstep + kstep, voffB);
        PG8_WAIT_V(6); PG8_BAR;
    }
    for (;;) {
        const bool has_next = S.next(ui + 1, nxt);
        const char* nA = has_next ? (const char*)g.A + (size_t)nxt.pm * tstep : cA; const char* nB = has_next ? (const char*)g.Bt + (size_t)nxt.pn * tstep : cB;
        for (int t = 0; t < nt; t += 2) {
            const bool last = (t == nt - 2);
            const char* a1 = cA + (size_t)(t + 1) * kstep;
            const char* a2 = last ? nA : cA + (size_t)(t + 2) * kstep; const char* b2 = last ? nB : cB + (size_t)(t + 2) * kstep;
            const char* a3 = a2 + kstep; const char* b3 = b2 + kstep;
            if (last && has_next) S.a_ready(nxt);
            if constexpr (SP2) {
            PG8_LDB(B0, 0, 0); PG8_LDB(B1, 0, 1); PG8_SCHED; PG8_LDA(At, 0, 0); PG8_STAGE(PG8_SA(1, 1), a1 + hstep, voffA);
            PG8_WAIT_V(8); PG8_WAIT_L(0); PG8_BAR; PG8_MMA(0, 0, At, B0); PG8_MMA(0, 1, At, B1); PG8_BAR; PG8_SCHED;
            PG8_LDA(At, 0, 1); PG8_STAGE(PG8_SB(0, 0), b2, voffB); PG8_STAGE(PG8_SB(0, 1), b2 + hstep, voffB); PG8_STAGE(PG8_SA(0, 0), a2, voffA);
            PG8_WAIT_V(8); PG8_WAIT_L(0); PG8_BAR; PG8_MMA(1, 0, At, B0); PG8_MMA(1, 1, At, B1); PG8_BAR; PG8_SCHED;
            PG8_LDB(B0, 1, 0); PG8_LDB(B1, 1, 1); PG8_SCHED; PG8_LDA(At, 1, 0); PG8_STAGE(PG8_SA(0, 1), a2 + hstep, voffA);
            PG8_WAIT_V(8); PG8_WAIT_L(0); PG8_BAR; PG8_MMA(0, 0, At, B0); PG8_MMA(0, 1, At, B1); PG8_BAR; PG8_SCHED;
            PG8_LDA(At, 1, 1); PG8_STAGE(PG8_SB(1, 0), b3, voffB); PG8_STAGE(PG8_SB(1, 1), b3 + hstep, voffB); PG8_STAGE(PG8_SA(1, 0), a3, voffA);
            PG8_WAIT_V(8); PG8_WAIT_L(0); PG8_BAR; PG8_MMA(1, 0, At, B0); PG8_MMA(1, 1, At, B1); PG8_BAR; PG8_SCHED;
            } else {
            PG8_LDB(B0, 0, 0); PG8_SCHED; PG8_LDA(At, 0, 0); PG8_STAGE(PG8_SA(1, 1), a1 + hstep, voffA);
            PG8_WAIT_L(8); PG8_BAR; PG8_WAIT_L(0); PG8_MMA(0, 0, At, B0); PG8_BAR; PG8_SCHED;
            PG8_LDB(B1, 0, 1); PG8_STAGE(PG8_SB(0, 0), b2, voffB);
            PG8_BAR; PG8_WAIT_L(0); PG8_MMA(0, 1, At, B1); PG8_BAR;
            PG8_LDA(At, 0, 1); PG8_STAGE(PG8_SA(0, 0), a2, voffA);
            PG8_BAR; PG8_WAIT_L(0); PG8_MMA(1, 0, At, B0); PG8_BAR; PG8_SCHED;
            PG8_STAGE(PG8_SB(0, 1), b2 + hstep, voffB);
            PG8_WAIT_V(6); PG8_BAR; PG8_MMA(1, 1, At, B1); PG8_BAR;
            PG8_LDB(B0, 1, 0); PG8_SCHED; PG8_LDA(At, 1, 0); PG8_STAGE(PG8_SA(0, 1), a2 + hstep, voffA);
            PG8_WAIT_L(8); PG8_BAR; PG8_WAIT_L(0); PG8_MMA(0, 0, At, B0); PG8_BAR; PG8_SCHED;
            PG8_LDB(B1, 1, 1); PG8_STAGE(PG8_SB(1, 0), b3, voffB);
            PG8_BAR; PG8_WAIT_L(0); PG8_MMA(0, 1, At, B1); PG8_BAR;
            PG8_LDA(At, 1, 1); PG8_STAGE(PG8_SA(1, 0), a3, voffA);
            PG8_BAR; PG8_WAIT_L(0); PG8_MMA(1, 0, At, B0); PG8_BAR; PG8_SCHED;
            PG8_STAGE(PG8_SB(1, 1), b3 + hstep, voffB);
            PG8_WAIT_V(6); PG8_BAR; PG8_MMA(1, 1, At, B1); PG8_BAR;
            }
        }
        if constexpr (ALIGN_EPI) { if (wr == 0) PG8_BAR; }
        if constexpr (!Epi::AFTER_DRAIN) { E(acc, cur, wr, wc, fr, fq); S.done(cur); }
        if (!has_next) break;
#pragma unroll
        for (int a = 0; a < 2; ++a)
#pragma unroll
            for (int b = 0; b < 2; ++b)
#pragma unroll
                for (int m = 0; m < 4; ++m)
#pragma unroll
                    for (int n = 0; n < 2; ++n) acc[a][b][m][n] = (f32x4){zf, zf, zf, zf};
        cur = nxt; cA = nA; cB = nB; ++ui;
        if constexpr (ALIGN_EPI) { if (wr == 1) PG8_BAR; }
    }
    PG8_WAIT_V(0);
    if constexpr (!ALIGN_EPI) { if (wr == 0) PG8_BAR; }
    PG8_BAR;
#undef PG8_SA
#undef PG8_SB
#undef PG8_STAGE
#undef PG8_LDA
#undef PG8_LDB
#undef PG8_MMA
#undef PG8_WAIT_V
#undef PG8_WAIT_L
#undef PG8_BAR
#undef PG8_SCHED
}
}

constexpr int NB = 4, SEQ = 2048, D = 2048, M = NB * SEQ, NH = 16, HD = 128, FF = 8192, DEPTH = 4, MODW = 6 * D;
constexpr int NQKV_A = 3 * D, NQKV_B = 9 * D;
constexpr int MLA_QR = 512, MLA_KVR = 512, MLA_ROPE = 64, MLA_IN = 1088, MLA_IN_PAD = 1280, MLA_QW = NH * 192, MLA_KVW = NH * 256;
constexpr float EPS = 1e-6f;
constexpr int NWAVES = 8;

constexpr size_t MiB = 1u << 20;
constexpr size_t WS_CTL = 0, CTL_ZERO_BYTES = 1 * MiB;
constexpr size_t WS_MOD = 1 * MiB;
constexpr size_t WS_WA_QKV = 2 * MiB;
constexpr size_t WS_WA_O = 50 * MiB;
constexpr size_t WS_WB_QKV = 66 * MiB;
constexpr size_t WS_WB_O = 138 * MiB;
constexpr size_t WS_WC_IN = 146 * MiB;
constexpr size_t WS_WC_UQ = 151 * MiB;
constexpr size_t WS_WC_UKV = 154 * MiB;
constexpr size_t WS_WC_O = 158 * MiB;
constexpr size_t WS_WUP = 166 * MiB;
constexpr size_t WS_WDN = 294 * MiB;
constexpr size_t WS_H = 422 * MiB;
constexpr size_t WS_U = 486 * MiB;
constexpr size_t WS_O = 518 * MiB;
constexpr size_t WS_QKV = 550 * MiB;
constexpr size_t WS_HID = 838 * MiB;
constexpr size_t WS_END = 966 * MiB;
constexpr size_t WS_C_HCAT = WS_QKV, WS_C_CQ = WS_QKV + 40 * MiB, WS_C_CKV = WS_QKV + 48 * MiB, WS_C_KR = WS_QKV + 56 * MiB, WS_C_Q = WS_QKV + 64 * MiB, WS_C_KV = WS_QKV + 112 * MiB;
constexpr int CW_BAR = 4096;

constexpr int RING_BYTES = 131072;
constexpr int LDSCTL_OFF = RING_BYTES, MISC_OFF = LDSCTL_OFF + 320;
constexpr int LDS_BYTES = 147456;

#define GAS __attribute__((address_space(1)))
#define LAS __attribute__((address_space(3)))
typedef unsigned short bf16;
typedef unsigned v4u __attribute__((ext_vector_type(4)));
typedef unsigned v2u __attribute__((ext_vector_type(2)));
typedef float f32x4 __attribute__((ext_vector_type(4)));
#define LDS_WAIT() asm volatile("s_waitcnt lgkmcnt(0)" ::: "memory")
#define VM_WAIT() asm volatile("s_waitcnt vmcnt(0)" ::: "memory")
__device__ __forceinline__ unsigned f2bf(float f) { unsigned u = __builtin_bit_cast(unsigned, f); return (u + 0x7fffu + ((u >> 16) & 1u)) >> 16; }
__device__ __forceinline__ unsigned pk2(float lo, float hi) { return f2bf(lo) | (f2bf(hi) << 16); }
__device__ __forceinline__ float bflo(unsigned w) { return __builtin_bit_cast(float, w << 16); }
__device__ __forceinline__ float bfhi(unsigned w) { return __builtin_bit_cast(float, w & 0xffff0000u); }
__device__ __forceinline__ float bf1(bf16 h) { return __builtin_bit_cast(float, ((unsigned)h) << 16); }

#define XB_TMO      128
#define XB_XCNT(j)  (256  + 64 * (j))
#define XB_XSUB(j)  (1280 + 64 * (j))
#define XB_XGEN(j)  (2304 + 64 * (j))
#define XB_TOP      3328
#define XB_TOPGEN   3392
#define XCD_BAR_WORDS 3456
#define XB_SPIN_CAP (1u << 18)

__device__ __forceinline__ unsigned xb_ld(unsigned* p)              { return __hip_atomic_load(p, __ATOMIC_RELAXED, __HIP_MEMORY_SCOPE_AGENT); }
__device__ __forceinline__ unsigned xb_add(unsigned* p, unsigned v) { return __hip_atomic_fetch_add(p, v, __ATOMIC_RELAXED, __HIP_MEMORY_SCOPE_AGENT); }
__device__ __forceinline__ unsigned xb_xcc_id() { return (unsigned)__builtin_amdgcn_s_getreg((3 << 11) | 20) & 0xFu; }
#define XB_SPIN(cond, bar) do { unsigned _sp = 0; while (cond) { __builtin_amdgcn_s_sleep(1); \
    if ((++_sp & 255u) == 0u) { if (xb_ld(&(bar)[XB_TMO])) break; if (_sp > XB_SPIN_CAP) { atomicAdd(&(bar)[XB_TMO], 1u); break; } } } } while (0)

struct XcdBarrier {
    unsigned* bar; unsigned x;
    volatile LAS unsigned* st;
};
__device__ __forceinline__ XcdBarrier xcd_barrier_post(unsigned* bar, volatile LAS unsigned* st) {
    XcdBarrier b; b.bar = bar; b.x = xb_xcc_id(); b.st = st;
    if (threadIdx.x == 0) (void)xb_add(&bar[XB_XCNT(b.x)], 1u);
    return b;
}
__device__ __forceinline__ void xcd_barrier_complete(unsigned* bar, unsigned x, unsigned& nloc, unsigned& nx) {
    const unsigned G = gridDim.x * gridDim.y * gridDim.z;
    unsigned sum, cnt, mine, sp = 0u;
    for (;;) {
        sum = 0u; cnt = 0u; mine = 0u;
#pragma unroll
        for (unsigned j = 0; j < 16; ++j) { const unsigned c = xb_ld(&bar[XB_XCNT(j)]); sum += c; cnt += (c > 0u) ? 1u : 0u; mine = (j == x) ? c : mine; }
        if (sum == G) break;
        __builtin_amdgcn_s_sleep(1);
        if ((++sp & 255u) == 0u) { if (xb_ld(&bar[XB_TMO])) break; if (sp > XB_SPIN_CAP) { atomicAdd(&bar[XB_TMO], 1u); break; } }
    }
    nloc = mine > 0u ? mine : 1u; nx = cnt > 0u ? cnt : 1u;
}
__device__ __forceinline__ void xcd_barrier(const XcdBarrier& b) {
    asm volatile("s_waitcnt vmcnt(0)" ::: "memory");
    __syncthreads();
    if (threadIdx.x == 0) {
        unsigned* bar = b.bar;
        __builtin_amdgcn_s_waitcnt(0);
        unsigned nloc = b.st[0], nx = b.st[1];
        if (nloc == 0u) { xcd_barrier_complete(bar, b.x, nloc, nx); b.st[0] = nloc; b.st[1] = nx; }
        const unsigned old = xb_add(&bar[XB_XSUB(b.x)], 1u);
        const unsigned gen = old / nloc;
        if (old + 1u == (gen + 1u) * nloc) {
            __builtin_amdgcn_fence(__ATOMIC_RELEASE, "agent");
            asm volatile("s_waitcnt vmcnt(0)" ::: "memory");
            const unsigned og = xb_add(&bar[XB_TOP], 1u);
            const unsigned tg = og / nx;
            if (og + 1u == (tg + 1u) * nx) xb_add(&bar[XB_TOPGEN], 1u);
            else XB_SPIN(xb_ld(&bar[XB_TOPGEN]) == tg, bar);
            __builtin_amdgcn_fence(__ATOMIC_ACQUIRE, "agent");
            xb_add(&bar[XB_XGEN(b.x)], 1u);
            asm volatile("s_waitcnt vmcnt(0)" ::: "memory");
        } else {
            XB_SPIN(xb_ld(&bar[XB_XGEN(b.x)]) == gen, bar);
            __builtin_amdgcn_fence(__ATOMIC_ACQUIRE, "agent");
            asm volatile("s_waitcnt vmcnt(0)" ::: "memory");
        }
    }
    __syncthreads();
}

__device__ __forceinline__ float wave_sum(float v) {
#pragma unroll
    for (int o = 1; o < 64; o <<= 1) v += __shfl_xor(v, o);
    return v;
}
__device__ __forceinline__ float wave_max(float v) {
#pragma unroll
    for (int o = 1; o < 64; o <<= 1) v = fmaxf(v, __shfl_xor(v, o));
    return v;
}
__device__ __forceinline__ void sincos_rev(float a, float& sn, float& cs) {
    float r = a * 0.15915494309189535f; r -= floorf(r);
    sn = __builtin_amdgcn_sinf(r); cs = __builtin_amdgcn_cosf(r);
}
__device__ __forceinline__ float rope_inv(int i, int half) { return exp2f(-(float)i * (13.287712379549449f / (float)half)); }

__device__ __forceinline__ void p0_transpose_item(const float* W, int K, int N, bf16* WT, LAS float* scr, int item, int lane) {
    const int nblk = N / 32, kb = item / nblk, nb = item % nblk, k0 = 64 * kb, n0 = 32 * nb;
#pragma unroll 8
    for (int i = 0; i < 32; ++i) { const int kk = 2 * i + (lane >> 5); scr[kk * 33 + (lane & 31)] = W[(size_t)(k0 + kk) * N + n0 + (lane & 31)]; }
    LDS_WAIT(); asm volatile("" ::: "memory");
    const int c = lane & 7;
#pragma unroll
    for (int j = 0; j < 4; ++j) { const int n = (lane >> 3) + 8 * j; const LAS float* s = scr + (8 * c) * 33 + n;
        v4u o; o.x = pk2(s[0 * 33], s[1 * 33]); o.y = pk2(s[2 * 33], s[3 * 33]); o.z = pk2(s[4 * 33], s[5 * 33]); o.w = pk2(s[6 * 33], s[7 * 33]);
        *(GAS v4u*)(WT + (size_t)(n0 + n) * K + k0 + 8 * c) = o; }
    LDS_WAIT(); asm volatile("" ::: "memory");
}

struct Args { const float* in[20]; float* out; unsigned char* ws; int ph_lo, ph_hi; };

#define PHASE_LOCALS unsigned char* wsl = ws_kernel; asm volatile("" : "+s"(wsl)); int tidl_ = threadIdx.x; asm volatile("" : "+v"(tidl_)); const int tid = tidl_, lane = tidl_ & 63; (void)tid; (void)lane
#define modbuf ((float*)(wsl + WS_MOD))
#define hbuf ((float*)(wsl + WS_H))
#define ubuf ((bf16*)(wsl + WS_U))
#define obuf ((bf16*)(wsl + WS_O))
#define qkvbuf ((bf16*)(wsl + WS_QKV))
#define hidbuf ((bf16*)(wsl + WS_HID))
#define mla_hcat ((float*)(wsl + WS_C_HCAT))
#define mla_cq ((bf16*)(wsl + WS_C_CQ))
#define mla_ckv ((bf16*)(wsl + WS_C_CKV))
#define mla_kr ((bf16*)(wsl + WS_C_KR))
#define mla_q ((bf16*)(wsl + WS_C_Q))
#define mla_kv ((bf16*)(wsl + WS_C_KV))
#define modl (modbuf + (size_t)L * 4 * MODW)
#define hin ((L == 0) ? args.in[0] : (const float*)hbuf)
#define RUN() (pid >= lo && pid < hi)
#define SEAM() do { if (MK_N_LAUNCHES == 1) { if (pid >= lo && pid + 1 < hi) xcd_barrier(bar); } ++pid; } while (0)
template <int L>
__device__ __forceinline__ void layer_body(const Args& args, LAS unsigned char* lds, const int wave, const int G, const int gw, const int NGW, const int lo, const int hi,
                                           unsigned char* const ws_kernel, const XcdBarrier& bar, int& pid) {
    constexpr int kind = L % 3, slot = L / 3;

        if (RUN() && PH_EN(1)) { PHASE_LOCALS;
            const float* gain = args.in[2] + L * D;
            for (int m = gw; m < M; m += NGW) {
                const int b = m >> 11; const float* mb = modl + (size_t)b * MODW;
                const f32x4* xr = (const f32x4*)(hin + (size_t)m * D) + lane; f32x4 v[8]; float ss = 0.f;
#pragma unroll
                for (int j = 0; j < 8; ++j) { v[j] = xr[64 * j]; ss += (v[j].x * v[j].x + v[j].y * v[j].y) + (v[j].z * v[j].z + v[j].w * v[j].w); }
                const float rstd = 1.0f / sqrtf(wave_sum(ss) * (1.0f / D) + EPS);
#pragma unroll
                for (int j = 0; j < 8; ++j) { const int col = 4 * lane + 256 * j;
                    const f32x4 g4 = *(const f32x4*)(gain + col), sh = *(const f32x4*)(mb + col), sc4 = *(const f32x4*)(mb + D + col);
                    const f32x4 y = (v[j] * rstd * g4) * (sc4 + 1.0f) + sh;
                    v2u o; o.x = pk2(y.x, y.y); o.y = pk2(y.z, y.w); *(v2u*)(ubuf + (size_t)m * D + col) = o; }
            }
        }
        SEAM();

        if constexpr (kind == 0) {
            if (RUN() && PH_EN(2)) { PHASE_LOCALS;
                pg8::Gemm g{ubuf, (const bf16*)(wsl + WS_WA_QKV) + (size_t)slot * NQKV_A * D, M, NQKV_A, D}; pg8::StaticOrder S; S.init(M, NQKV_A, G, (int)blockIdx.x);
                pg8::EpiBf16<0> E{qkvbuf, NQKV_A};
                pg8::gemm_phase<pg8::EpiBf16<0>, pg8::StaticOrder, true, true>(lds, g, S, E);
            }
            SEAM();
            if (RUN() && PH_EN(3)) { PHASE_LOCALS;
                LAS float* qs = (LAS float*)(lds + wave * 12288); LAS float* ps = qs + 256;
                const float* rpb = args.in[8] + (size_t)slot * NH * 15 * 31;
                const float scale = 0.08838834764831845f;
                for (int unit = gw; unit < M * NH; unit += NGW) {
                    const int h = unit & 15, tok = unit >> 4, b = tok >> 11, s = tok & 2047, r = s >> 6, c = s & 63;
                    const int r0 = min(max(r - 4, 0), 24), c0 = min(max(c - 8, 0), 48);
                    { const unsigned qw = *(const unsigned*)(qkvbuf + (size_t)tok * NQKV_A + h * HD + 2 * lane); qs[2 * lane] = bflo(qw); qs[2 * lane + 1] = bfhi(qw); }
                    LDS_WAIT();
                    float sc[2];
#pragma unroll
                    for (int rep = 0; rep < 2; ++rep) {
                        const int kk = lane + 64 * rep, kr = r0 + (kk >> 4), kc = c0 + (kk & 15);
                        const bf16* kp = qkvbuf + (size_t)(b * SEQ + kr * 64 + kc) * NQKV_A + D + h * HD;
                        float dot = 0.f;
#pragma unroll
                        for (int ch = 0; ch < 16; ++ch) { const v4u kv = *(const v4u*)(kp + 8 * ch); const f32x4 qa = *(const LAS f32x4*)(qs + 8 * ch), qb = *(const LAS f32x4*)(qs + 8 * ch + 4);
                            dot += bflo(kv.x) * qa.x + bfhi(kv.x) * qa.y + bflo(kv.y) * qa.z + bfhi(kv.y) * qa.w + bflo(kv.z) * qb.x + bfhi(kv.z) * qb.y + bflo(kv.w) * qb.z + bfhi(kv.w) * qb.w; }
                        sc[rep] = dot * scale + rpb[(h * 15 + (kr - r + 7)) * 31 + (kc - c + 15)];
                    }
                    const float mx = wave_max(fmaxf(sc[0], sc[1]));
                    const float p0 = __expf(sc[0] - mx), p1 = __expf(sc[1] - mx);
                    const float inv = 1.0f / wave_sum(p0 + p1);
                    ps[lane] = p0 * inv; ps[lane + 64] = p1 * inv;
                    LDS_WAIT();
                    float a0 = 0.f, a1 = 0.f;
                    const bf16* vbase = qkvbuf + (size_t)(b * SEQ) * NQKV_A + 2 * D + h * HD + 2 * lane;
#pragma unroll 8
                    for (int kk = 0; kk < 128; ++kk) { const int kt = (r0 + (kk >> 4)) * 64 + c0 + (kk & 15);
                        const unsigned vw = *(const unsigned*)(vbase + (size_t)kt * NQKV_A); const float p = ps[kk]; a0 += p * bflo(vw); a1 += p * bfhi(vw); }
                    *(unsigned*)(obuf + (size_t)tok * D + h * HD + 2 * lane) = pk2(a0, a1);
                    LDS_WAIT();
                }
            }
            SEAM();
        } else if constexpr (kind == 1) {
            if (RUN() && PH_EN(4)) { PHASE_LOCALS;
                pg8::Gemm g{ubuf, (const bf16*)(wsl + WS_WB_QKV), M, NQKV_B, D}; pg8::StaticOrder S; S.init(M, NQKV_B, G, (int)blockIdx.x);
                pg8::EpiBf16<0> E{qkvbuf, NQKV_B};
                pg8::gemm_phase<pg8::EpiBf16<0>, pg8::StaticOrder, true, true>(lds, g, S, E);
            }
            SEAM();
            if (RUN() && PH_EN(5)) { PHASE_LOCALS;
                const int i0 = 4 * (lane & 15);
                float inv[4];
#pragma unroll
                for (int k = 0; k < 4; ++k) inv[k] = rope_inv(i0 + k, 64);
                for (int task = gw; task < M * 3; task += NGW) {
                    const int tok = task / 3, g = task - tok * 3, s = tok & 2047;
                    float cs[4], sn[4];
#pragma unroll
                    for (int k = 0; k < 4; ++k) sincos_rev((float)s * inv[k], sn[k], cs[k]);
                    bf16* base = qkvbuf + (size_t)tok * NQKV_B + g * NQKV_A;
#pragma unroll
                    for (int it = 0; it < 8; ++it) { bf16* p = base + (it * 4 + (lane >> 4)) * HD + i0;
                        const v2u a = *(const v2u*)p, bq = *(const v2u*)(p + 64);
                        const float x1[4] = {bflo(a.x), bfhi(a.x), bflo(a.y), bfhi(a.y)}, x2[4] = {bflo(bq.x), bfhi(bq.x), bflo(bq.y), bfhi(bq.y)};
                        float o1[4], o2[4];
#pragma unroll
                        for (int k = 0; k < 4; ++k) { o1[k] = x1[k] * cs[k] - x2[k] * sn[k]; o2[k] = x2[k] * cs[k] + x1[k] * sn[k]; }
                        v2u wa, wb; wa.x = pk2(o1[0], o1[1]); wa.y = pk2(o1[2], o1[3]); wb.x = pk2(o2[0], o2[1]); wb.y = pk2(o2[2], o2[3]);
                        *(v2u*)p = wa; *(v2u*)(p + 64) = wb; }
                }
            }
            SEAM();
            if (RUN() && PH_EN(6)) { PHASE_LOCALS;
                LAS float* qs = (LAS float*)(lds + wave * 12288); LAS float* ps = qs + 256;
                const float scale = 0.08838834764831845f;
                for (int unit = gw; unit < M * NH; unit += NGW) {
                    const int h = unit & 15, tok = unit >> 4, b = tok >> 11, s = tok & 2047;
                    float sc[3][3];
#pragma unroll
                    for (int g = 0; g < 3; ++g) {
                        const int dil = (g == 0) ? 1 : (g == 1 ? 4 : 16);
                        { const unsigned qw = *(const unsigned*)(qkvbuf + (size_t)tok * NQKV_B + g * NQKV_A + h * HD + 2 * lane); qs[2 * lane] = bflo(qw); qs[2 * lane + 1] = bfhi(qw); }
                        LDS_WAIT();
#pragma unroll
                        for (int rep = 0; rep < 3; ++rep) {
                            const int jj = lane + 64 * rep, t = s + (jj - 64) * dil; const bool valid = (jj <= 128) && (t >= 0) && (t < SEQ);
                            const int tc = valid ? t : s;
                            const bf16* kp = qkvbuf + (size_t)(b * SEQ + tc) * NQKV_B + g * NQKV_A + D + h * HD;
                            float dot = 0.f;
#pragma unroll
                            for (int ch = 0; ch < 16; ++ch) { const v4u kv = *(const v4u*)(kp + 8 * ch); const f32x4 qa = *(const LAS f32x4*)(qs + 8 * ch), qb = *(const LAS f32x4*)(qs + 8 * ch + 4);
                                dot += bflo(kv.x) * qa.x + bfhi(kv.x) * qa.y + bflo(kv.y) * qa.z + bfhi(kv.y) * qa.w + bflo(kv.z) * qb.x + bfhi(kv.z) * qb.y + bflo(kv.w) * qb.z + bfhi(kv.w) * qb.w; }
                            sc[g][rep] = valid ? dot * scale : -1e30f;
                        }
                        LDS_WAIT();
                    }
                    float mx = -1e30f;
#pragma unroll
                    for (int g = 0; g < 3; ++g)
#pragma unroll
                        for (int rep = 0; rep < 3; ++rep) mx = fmaxf(mx, sc[g][rep]);
                    mx = wave_max(mx);
                    float sum = 0.f;
#pragma unroll
                    for (int g = 0; g < 3; ++g)
#pragma unroll
                        for (int rep = 0; rep < 3; ++rep) { sc[g][rep] = __expf(sc[g][rep] - mx); sum += sc[g][rep]; }
                    const float inv = 1.0f / wave_sum(sum);
#pragma unroll
                    for (int g = 0; g < 3; ++g)
#pragma unroll
                        for (int rep = 0; rep < 3; ++rep) ps[g * 192 + lane + 64 * rep] = sc[g][rep] * inv;
                    LDS_WAIT();
                    float a0 = 0.f, a1 = 0.f;
#pragma unroll
                    for (int g = 0; g < 3; ++g) {
                        const int dil = (g == 0) ? 1 : (g == 1 ? 4 : 16);
                        const bf16* vbase = qkvbuf + (size_t)(b * SEQ) * NQKV_B + g * NQKV_A + 2 * D + h * HD + 2 * lane;
                        const int jlo = max(0, 64 - s / dil), jhi = min(128, 64 + (SEQ - 1 - s) / dil);
                        for (int jj = jlo; jj <= jhi; ++jj) { const int t = s + (jj - 64) * dil;
                            const unsigned vw = *(const unsigned*)(vbase + (size_t)t * NQKV_B); const float p = ps[g * 192 + jj]; a0 += p * bflo(vw); a1 += p * bfhi(vw); }
                    }
                    *(unsigned*)(obuf + (size_t)tok * D + h * HD + 2 * lane) = pk2(a0, a1);
                    LDS_WAIT();
                }
            }
            SEAM();
        } else {
            if (RUN() && PH_EN(7)) { PHASE_LOCALS;
                pg8::Gemm g{ubuf, (const bf16*)(wsl + WS_WC_IN), M, MLA_IN_PAD, D}; pg8::StaticOrder S; S.init(M, MLA_IN_PAD, G, (int)blockIdx.x);
                pg8::EpiF32 E{mla_hcat, MLA_IN_PAD};
                pg8::gemm_phase<pg8::EpiF32, pg8::StaticOrder, true, true>(lds, g, S, E);
            }
            SEAM();
            if (RUN() && PH_EN(8)) { PHASE_LOCALS;
                const float* qn = args.in[12]; const float* kn = args.in[13];
                const float kinv = rope_inv(lane & 31, 32);
                for (int m = gw; m < M; m += NGW) {
                    const float* hr = mla_hcat + (size_t)m * MLA_IN_PAD; const int s = m & 2047;
#pragma unroll
                    for (int part = 0; part < 2; ++part) {
                        const float* src = hr + part * 512 + 8 * lane; const float* gn = (part == 0 ? qn : kn) + 8 * lane;
                        const f32x4 a = *(const f32x4*)src, b4 = *(const f32x4*)(src + 4);
                        const float ss = wave_sum((a.x * a.x + a.y * a.y) + (a.z * a.z + a.w * a.w) + (b4.x * b4.x + b4.y * b4.y) + (b4.z * b4.z + b4.w * b4.w));
                        const float rstd = 1.0f / sqrtf(ss * (1.0f / 512.0f) + EPS);
                        const f32x4 g0 = *(const f32x4*)gn, g1 = *(const f32x4*)(gn + 4);
                        v4u o; o.x = pk2(a.x * rstd * g0.x, a.y * rstd * g0.y); o.y = pk2(a.z * rstd * g0.z, a.w * rstd * g0.w);
                        o.z = pk2(b4.x * rstd * g1.x, b4.y * rstd * g1.y); o.w = pk2(b4.z * rstd * g1.z, b4.w * rstd * g1.w);
                        *(v4u*)((part == 0 ? mla_cq : mla_ckv) + (size_t)m * 512 + 8 * lane) = o;
                    }
                    { const int i = lane & 31; const float x1 = hr[1024 + i], x2 = hr[1024 + 32 + i]; float sn, cs; sincos_rev((float)s * kinv, sn, cs);
                      const float o = (lane < 32) ? (x1 * cs - x2 * sn) : (x2 * cs + x1 * sn);
                      mla_kr[(size_t)m * 64 + lane] = (bf16)f2bf(o); }
                }
            }
            SEAM();
            if (RUN() && PH_EN(9)) { PHASE_LOCALS;
                { pg8::Gemm g{mla_cq, (const bf16*)(wsl + WS_WC_UQ), M, MLA_QW, MLA_QR}; pg8::StaticOrder S; S.init(M, MLA_QW, G, (int)blockIdx.x);
                  pg8::EpiBf16<0> E{mla_q, MLA_QW};
                  pg8::gemm_phase<pg8::EpiBf16<0>, pg8::StaticOrder, true, true>(lds, g, S, E); }
                { pg8::Gemm g{mla_ckv, (const bf16*)(wsl + WS_WC_UKV), M, MLA_KVW, MLA_KVR}; pg8::StaticOrder S; S.init(M, MLA_KVW, G, (int)blockIdx.x);
                  pg8::EpiBf16<0> E{mla_kv, MLA_KVW};
                  pg8::gemm_phase<pg8::EpiBf16<0>, pg8::StaticOrder, true, true>(lds, g, S, E); }
            }
            SEAM();
            if (RUN() && PH_EN(10)) { PHASE_LOCALS;
                const float qinv = rope_inv(lane & 31, 32);
                for (int m = gw; m < M; m += NGW) {
                    const int s = m & 2047; float sn, cs; sincos_rev((float)s * qinv, sn, cs);
#pragma unroll
                    for (int it = 0; it < 8; ++it) { const int h = (lane >> 5) + 2 * it; bf16* p = mla_q + (size_t)m * MLA_QW + h * 192 + 128 + (lane & 31);
                        const float x1 = bf1(p[0]), x2 = bf1(p[32]); p[0] = (bf16)f2bf(x1 * cs - x2 * sn); p[32] = (bf16)f2bf(x2 * cs + x1 * sn); }
                }
            }
            SEAM();
            if (RUN() && PH_EN(11)) { PHASE_LOCALS;
                LAS float* qs = (LAS float*)(lds + wave * 12288); LAS float* ps = qs + 256;
                const float scale = 0.07216878364870323f;
                for (int unit = gw; unit < M * NH; unit += NGW) {
                    const int h = unit & 15, tok = unit >> 4, b = tok >> 11;
                    { const bf16* qp = mla_q + (size_t)tok * MLA_QW + h * 192;
#pragma unroll
                      for (int j = 0; j < 3; ++j) qs[lane + 64 * j] = bf1(qp[lane + 64 * j]); }
                    LDS_WAIT();
                    float sc[32];
#pragma unroll
                    for (int rep = 0; rep < 32; ++rep) {
                        const int key = b * SEQ + lane + 64 * rep;
                        const bf16* kp = mla_kv + (size_t)key * MLA_KVW + h * 256; const bf16* rp = mla_kr + (size_t)key * 64;
                        float dot = 0.f;
#pragma unroll
                        for (int cg = 0; cg < 3; ++cg) {
#pragma unroll
                            for (int c8 = 0; c8 < 8; ++c8) { const int ch = cg * 8 + c8; const v4u kv = (ch < 16) ? *(const v4u*)(kp + 8 * ch) : *(const v4u*)(rp + 8 * (ch - 16));
                                const f32x4 qa = *(const LAS f32x4*)(qs + 8 * ch), qb4 = *(const LAS f32x4*)(qs + 8 * ch + 4);
                                dot += bflo(kv.x) * qa.x + bfhi(kv.x) * qa.y + bflo(kv.y) * qa.z + bfhi(kv.y) * qa.w + bflo(kv.z) * qb4.x + bfhi(kv.z) * qb4.y + bflo(kv.w) * qb4.z + bfhi(kv.w) * qb4.w; }
                            asm volatile("" ::: "memory"); }
                        sc[rep] = dot * scale;
                    }
                    float mx = sc[0];
#pragma unroll
                    for (int rep = 1; rep < 32; ++rep) mx = fmaxf(mx, sc[rep]);
                    mx = wave_max(mx);
                    float sum = 0.f;
#pragma unroll
                    for (int rep = 0; rep < 32; ++rep) { sc[rep] = __expf(sc[rep] - mx); sum += sc[rep]; }
                    const float inv = 1.0f / wave_sum(sum);
#pragma unroll
                    for (int rep = 0; rep < 32; ++rep) ps[lane + 64 * rep] = sc[rep] * inv;
                    LDS_WAIT();
                    float a0 = 0.f, a1 = 0.f;
                    const bf16* vbase = mla_kv + (size_t)(b * SEQ) * MLA_KVW + h * 256 + 128 + 2 * lane;
#pragma unroll 8
                    for (int key = 0; key < SEQ; ++key) { const unsigned vw = *(const unsigned*)(vbase + (size_t)key * MLA_KVW); const float p = ps[key]; a0 += p * bflo(vw); a1 += p * bfhi(vw); }
                    *(unsigned*)(obuf + (size_t)tok * D + h * HD + 2 * lane) = pk2(a0, a1);
                    LDS_WAIT();
                }
            }
            SEAM();
        }

        if (RUN() && PH_EN(12)) { PHASE_LOCALS;
            const bf16* Wo = (kind == 0) ? (const bf16*)(wsl + WS_WA_O) + (size_t)slot * D * D : (kind == 1 ? (const bf16*)(wsl + WS_WB_O) : (const bf16*)(wsl + WS_WC_O));
            pg8::Gemm g{obuf, Wo, M, D, D}; pg8::StaticOrder S; S.init(M, D, G, (int)blockIdx.x);
            pg8::EpiGateRes E{hin, hbuf, D, modl + 2 * D, MODW};
            pg8::gemm_phase<pg8::EpiGateRes, pg8::StaticOrder, true, true>(lds, g, S, E);
        }
        SEAM();

        if (RUN() && PH_EN(13)) { PHASE_LOCALS;
            const float* gain = args.in[3] + L * D;
            for (int m = gw; m < M; m += NGW) {
                const int b = m >> 11; const float* mb = modl + (size_t)b * MODW + 3 * D;
                const f32x4* xr = (const f32x4*)(hbuf + (size_t)m * D) + lane; f32x4 v[8]; float ss = 0.f;
#pragma unroll
                for (int j = 0; j < 8; ++j) { v[j] = xr[64 * j]; ss += (v[j].x * v[j].x + v[j].y * v[j].y) + (v[j].z * v[j].z + v[j].w * v[j].w); }
                const float rstd = 1.0f / sqrtf(wave_sum(ss) * (1.0f / D) + EPS);
#pragma unroll
                for (int j = 0; j < 8; ++j) { const int col = 4 * lane + 256 * j;
                    const f32x4 g4 = *(const f32x4*)(gain + col), sh = *(const f32x4*)(mb + col), sc4 = *(const f32x4*)(mb + D + col);
                    const f32x4 y = (v[j] * rstd * g4) * (sc4 + 1.0f) + sh;
                    v2u o; o.x = pk2(y.x, y.y); o.y = pk2(y.z, y.w); *(v2u*)(ubuf + (size_t)m * D + col) = o; }
            }
        }
        SEAM();

        if (RUN() && PH_EN(14)) { PHASE_LOCALS;
            pg8::Gemm g{ubuf, (const bf16*)(wsl + WS_WUP) + (size_t)L * FF * D, M, FF, D}; pg8::StaticOrder S; S.init(M, FF, G, (int)blockIdx.x);
            pg8::EpiBf16<1> E{hidbuf, FF};
            pg8::gemm_phase<pg8::EpiBf16<1>, pg8::StaticOrder, true, true>(lds, g, S, E);
        }
        SEAM();

        if (RUN() && PH_EN(15)) { PHASE_LOCALS;
            pg8::Gemm g{hidbuf, (const bf16*)(wsl + WS_WDN) + (size_t)L * D * FF, M, D, FF}; pg8::StaticOrder S; S.init(M, D, G, (int)blockIdx.x);
            pg8::EpiGateRes E{hbuf, hbuf, D, modl + 5 * D, MODW};
            pg8::gemm_phase<pg8::EpiGateRes, pg8::StaticOrder, true, true>(lds, g, S, E);
        }
        SEAM();
}

__global__ void __launch_bounds__(NWAVES * 64, 2) fwd_kernel(Args args) {
    extern __shared__ __attribute__((aligned(16))) unsigned char lds_raw[];
    LAS unsigned char* lds = (LAS unsigned char*)lds_raw;
    volatile LAS unsigned* MISC = (volatile LAS unsigned*)(lds + MISC_OFF);
    const int tid = threadIdx.x, lane = tid & 63, wave = __builtin_amdgcn_readfirstlane(tid >> 6);
    const int G = gridDim.x;
    const int gw = blockIdx.x * NWAVES + wave, NGW = G * NWAVES;
    unsigned char* const ws_kernel = args.ws;
    for (int u = tid; u < (LDS_BYTES - LDSCTL_OFF) / 4; u += NWAVES * 64) ((LAS unsigned*)(lds + LDSCTL_OFF))[u] = 0u;
    __syncthreads();
    XcdBarrier bar; bar.bar = (unsigned*)(ws_kernel + WS_CTL) + CW_BAR; bar.x = 0; bar.st = nullptr;
    if (MK_N_LAUNCHES == 1) bar = xcd_barrier_post((unsigned*)(ws_kernel + WS_CTL) + CW_BAR, MISC + 8);
    const int lo = args.ph_lo, hi = args.ph_hi;
    int pid = 0;


    if (RUN() && PH_EN(0)) { PHASE_LOCALS;
        {
            LAS float* sc = (LAS float*)lds; LAS float* red = (LAS float*)(lds + 32768);
            const float* cc = args.in[1];
            for (int i = tid; i < NB * D; i += NWAVES * 64) { const float xv = cc[i]; sc[i] = xv / (1.0f + __expf(-xv)); }
            __syncthreads();
            for (int task = blockIdx.x; task < 256; task += G) {
                const int l = task >> 6, cg = task & 63;
                f32x4 acc[4];
#pragma unroll
                for (int b = 0; b < 4; ++b) acc[b] = (f32x4){0.f, 0.f, 0.f, 0.f};
                if (lane < 48) {
                    const float* Wp = args.in[4] + ((size_t)l * D + (size_t)wave * 256) * MODW + cg * 192 + 4 * lane;
                    for (int d = 0; d < 256; d += 8) {
                        f32x4 w[8];
#pragma unroll
                        for (int j = 0; j < 8; ++j) w[j] = *(const f32x4*)(Wp + (size_t)(d + j) * MODW);
#pragma unroll
                        for (int j = 0; j < 8; ++j)
#pragma unroll
                            for (int b = 0; b < 4; ++b) acc[b] += sc[b * D + wave * 256 + d + j] * w[j];
                    }
#pragma unroll
                    for (int b = 0; b < 4; ++b) *(LAS f32x4*)(red + (wave * 4 + b) * 192 + 4 * lane) = acc[b];
                }
                __syncthreads();
                for (int i = tid; i < 4 * 192; i += NWAVES * 64) { const int b = i / 192, c2 = i % 192; float s = args.in[5][l * MODW + cg * 192 + c2];
#pragma unroll
                    for (int w = 0; w < 8; ++w) s += red[(w * 4 + b) * 192 + c2];
                    modbuf[(size_t)(l * 4 + b) * MODW + cg * 192 + c2] = s; }
                __syncthreads();
            }
        }
        {
            LAS float* scr = (LAS float*)(lds + wave * 16384);
            constexpr int I_AQ = (D / 64) * (NQKV_A / 32), I_DD = (D / 64) * (D / 32), I_BQ = (D / 64) * (NQKV_B / 32), I_CIN = (D / 64) * (MLA_IN / 32),
                          I_UQ = (MLA_QR / 64) * (MLA_QW / 32), I_UKV = (MLA_KVR / 64) * (MLA_KVW / 32), I_UP = (D / 64) * (FF / 32), I_DN = (FF / 64) * (D / 32);
            constexpr int NITEMS = 2 * I_AQ + 2 * I_DD + I_BQ + I_DD + I_CIN + I_UQ + I_UKV + I_DD + 4 * I_UP + 4 * I_DN;
            for (int it = gw; it < NITEMS; it += NGW) {
                int r = it; const float* W; int K, N; bf16* WT;
                if (r < 2 * I_AQ) { const int s = r / I_AQ; r -= s * I_AQ; W = args.in[6] + (size_t)s * D * NQKV_A; K = D; N = NQKV_A; WT = (bf16*)(wsl + WS_WA_QKV) + (size_t)s * NQKV_A * D; }
                else if ((r -= 2 * I_AQ) < 2 * I_DD) { const int s = r / I_DD; r -= s * I_DD; W = args.in[7] + (size_t)s * D * D; K = D; N = D; WT = (bf16*)(wsl + WS_WA_O) + (size_t)s * D * D; }
                else if ((r -= 2 * I_DD) < I_BQ) { W = args.in[9]; K = D; N = NQKV_B; WT = (bf16*)(wsl + WS_WB_QKV); }
                else if ((r -= I_BQ) < I_DD) { W = args.in[10]; K = D; N = D; WT = (bf16*)(wsl + WS_WB_O); }
                else if ((r -= I_DD) < I_CIN) { W = args.in[11]; K = D; N = MLA_IN; WT = (bf16*)(wsl + WS_WC_IN); }
                else if ((r -= I_CIN) < I_UQ) { W = args.in[14]; K = MLA_QR; N = MLA_QW; WT = (bf16*)(wsl + WS_WC_UQ); }
                else if ((r -= I_UQ) < I_UKV) { W = args.in[15]; K = MLA_KVR; N = MLA_KVW; WT = (bf16*)(wsl + WS_WC_UKV); }
                else if ((r -= I_UKV) < I_DD) { W = args.in[16]; K = D; N = D; WT = (bf16*)(wsl + WS_WC_O); }
                else if ((r -= I_DD) < 4 * I_UP) { const int s = r / I_UP; r -= s * I_UP; W = args.in[17] + (size_t)s * D * FF; K = D; N = FF; WT = (bf16*)(wsl + WS_WUP) + (size_t)s * FF * D; }
                else { r -= 4 * I_UP; const int s = r / I_DN; r -= s * I_DN; W = args.in[18] + (size_t)s * FF * D; K = FF; N = D; WT = (bf16*)(wsl + WS_WDN) + (size_t)s * D * FF; }
                p0_transpose_item(W, K, N, WT, scr, r, lane);
            }
            { v4u* z = (v4u*)((bf16*)(wsl + WS_WC_IN) + (size_t)MLA_IN * D); const int nz = (MLA_IN_PAD - MLA_IN) * D / 8;
              for (int i = blockIdx.x * (NWAVES * 64) + tid; i < nz; i += G * NWAVES * 64) z[i] = (v4u){0u, 0u, 0u, 0u}; }
        }
    }
    SEAM();

    layer_body<0>(args, lds, wave, G, gw, NGW, lo, hi, ws_kernel, bar, pid);
    layer_body<1>(args, lds, wave, G, gw, NGW, lo, hi, ws_kernel, bar, pid);
    layer_body<2>(args, lds, wave, G, gw, NGW, lo, hi, ws_kernel, bar, pid);
    layer_body<3>(args, lds, wave, G, gw, NGW, lo, hi, ws_kernel, bar, pid);

    if (RUN() && PH_EN(16)) { PHASE_LOCALS;
        const float* gain = args.in[19];
        for (int m = gw; m < M; m += NGW) {
            const f32x4* xr = (const f32x4*)(hbuf + (size_t)m * D) + lane; f32x4 v[8]; float ss = 0.f;
#pragma unroll
            for (int j = 0; j < 8; ++j) { v[j] = xr[64 * j]; ss += (v[j].x * v[j].x + v[j].y * v[j].y) + (v[j].z * v[j].z + v[j].w * v[j].w); }
            const float rstd = 1.0f / sqrtf(wave_sum(ss) * (1.0f / D) + EPS);
#pragma unroll
            for (int j = 0; j < 8; ++j) { const int col = 4 * lane + 256 * j; const f32x4 g4 = *(const f32x4*)(gain + col);
                *(f32x4*)(args.out + (size_t)m * D + col) = v[j] * rstd * g4; }
        }
    }
    ++pid;
}

constexpr int NPH_MAX = 48;

extern "C" void kernel_launch(void* const* d_in, const int* in_sizes, int n_in, void* d_out, int out_size, void* d_ws, size_t ws_size, hipStream_t stream) {
    static int grid = 0;
    if (grid == 0) {
        if (n_in != 20 || out_size != M * D || ws_size < WS_END) { fprintf(stderr, "kernel_launch: unexpected shapes (n_in %d out %d ws %zu); nothing launched\n", n_in, out_size, ws_size); grid = -1; return; }
        int dev = 0, cus = 0, per_cu = 0;
        if (hipGetDevice(&dev) != hipSuccess || hipDeviceGetAttribute(&cus, hipDeviceAttributeMultiprocessorCount, dev) != hipSuccess) { grid = -1; return; }
        if (hipFuncSetAttribute((const void*)fwd_kernel, hipFuncAttributeMaxDynamicSharedMemorySize, LDS_BYTES) != hipSuccess) { fprintf(stderr, "kernel_launch: hipFuncSetAttribute failed\n"); grid = -1; return; }
        if (hipOccupancyMaxActiveBlocksPerMultiprocessor(&per_cu, (const void*)fwd_kernel, NWAVES * 64, LDS_BYTES) != hipSuccess || per_cu < 1)
            fprintf(stderr, "kernel_launch: note: occupancy query reports %d workgroups per CU\n", per_cu);
        (void)hipGetLastError();
        grid = cus;
    }
    if (grid < 0) return;
    if (hipMemsetAsync((char*)d_ws + WS_CTL, 0, CTL_ZERO_BYTES, stream) != hipSuccess) return;
    Args a{};
    for (int i = 0; i < 20; ++i) a.in[i] = (const float*)d_in[i];
    a.out = (float*)d_out; a.ws = (unsigned char*)d_ws;
#if MK_N_LAUNCHES == 1
    a.ph_lo = 0; a.ph_hi = 1 << 20;
    hipLaunchKernelGGL(fwd_kernel, dim3(grid), dim3(NWAVES * 64), LDS_BYTES, stream, a);
#else
    for (int p = 0; p < NPH_MAX; ++p) { a.ph_lo = p; a.ph_hi = p + 1; hipLaunchKernelGGL(fwd_kernel, dim3(grid), dim3(NWAVES * 64), LDS_BYTES, stream, a); }
#endif
    const hipError_t le = hipPeekAtLastError();
    if (le != hipSuccess) fprintf(stderr, "kernel_launch: launch failed: %s\n", hipGetErrorName(le));
}
```

```cpp
#include <hip/hip_runtime.h>
#include <cstdio>
#include <cstdint>

#ifndef PHMASK
#define PHMASK 0xFFFFFFFFu
#endif
#define PH_EN(k) (((PHMASK) >> (k)) & 1u)
#ifndef MK_N_LAUNCHES
#define MK_N_LAUNCHES 1
#endif

namespace pg8 {
#define PG8_LAS __attribute__((address_space(3)))
typedef unsigned short bf16_t;
typedef short bf16x8 __attribute__((ext_vector_type(8)));
typedef float f32x4 __attribute__((ext_vector_type(4)));
typedef unsigned u32x4 __attribute__((ext_vector_type(4)));
constexpr int BM = 256, BK = 64, HALF = 128, HTB = HALF * BK * 2  , STAGE_BYTES = 8 * HTB, NXCD = 8, WGM = 8;

__host__ __device__ __forceinline__ int lds_byte(int r, int c) { const int st = (r >> 4) * 2 + (c >> 5), rr = r & 15, cc = c & 31, ob = rr * 64 + cc * 2; return st * 1024 + (ob ^ (((ob >> 9) & 1) << 5)); }
__host__ __device__ __forceinline__ void stage_rc(int b, int& R, int& C) { const int st = b / 1024, sb = b % 1024, swz = sb ^ (((sb >> 9) & 1) << 5); R = (st >> 1) * 16 + swz / 64; C = (st & 1) * 32 + (swz % 64) / 2; }
__host__ __device__ __forceinline__ int perm32(int rho) { const int n = rho >> 4, i = rho & 15; return 8 * (i >> 2) + 4 * n + (i & 3); }

struct Unit { int pm, pn; };
struct Gemm { const bf16_t* A; const bf16_t* Bt; int M, N, K; };

struct StaticOrder {
    int nM, nN, nwg, G, c;
    __host__ __device__ void init(int M, int N, int G_, int c_) { nM = M / BM; nN = N / BM; nwg = nM * nN; G = G_; c = c_; }
    __host__ __device__ bool next(int i, Unit& u) const {
        const long L = (long)i * G + c; if (L >= nwg) return false;
        int wgid = (int)L; { const int q = nwg / NXCD, r = nwg % NXCD, xcd = wgid % NXCD, off = wgid / NXCD; wgid = (xcd < r ? xcd * (q + 1) : r * (q + 1) + (xcd - r) * q) + off; }
        const int nig = WGM * nN, gid = wgid / nig, fm = gid * WGM, gsz = (nM - fm) < WGM ? (nM - fm) : WGM;
        u.pm = fm + ((wgid % nig) % gsz); u.pn = (wgid % nig) / gsz; return true;
    }
    __device__ __forceinline__ void a_ready(const Unit&) const {}
    __device__ __forceinline__ void done(const Unit&) const {}
};

__device__ __forceinline__ unsigned cvt_pk_bf16(float lo, float hi) { unsigned r; asm volatile("v_cvt_pk_bf16_f32 %0, %1, %2" : "=v"(r) : "v"(lo), "v"(hi)); return r; }

template <int ACT  > struct EpiBf16 {
    static constexpr bool PERM = true, AFTER_DRAIN = false;
    bf16_t* O; int ldc;
    __device__ __forceinline__ void operator()(const f32x4 (&acc)[2][2][4][2], const Unit& u, int wr, int wc, int fr, int fq) const {
        const int row0 = u.pm * BM + wr * 64 + fr; const int col0 = u.pn * BM + wc * 32 + 8 * fq;
#pragma unroll
        for (int ai = 0; ai < 2; ++ai)
#pragma unroll
            for (int m = 0; m < 4; ++m) { bf16_t* rowp = O + (size_t)(row0 + ai * HALF + m * 16) * ldc + col0;
#pragma unroll
                for (int bj = 0; bj < 2; ++bj) { f32x4 v0 = acc[ai][bj][m][0], v1 = acc[ai][bj][m][1];
                    if (ACT == 1) {
#pragma unroll
                        for (int j = 0; j < 4; ++j) { const float a = fmaxf(v0[j], 0.f), b = fmaxf(v1[j], 0.f); v0[j] = a * a; v1[j] = b * b; } }
                    u32x4 w; w.x = cvt_pk_bf16(v0[0], v0[1]); w.y = cvt_pk_bf16(v0[2], v0[3]); w.z = cvt_pk_bf16(v1[0], v1[1]); w.w = cvt_pk_bf16(v1[2], v1[3]);
                    *(u32x4*)(rowp + bj * HALF) = w; } }
    }
};
struct EpiF32 {
    static constexpr bool PERM = false, AFTER_DRAIN = false;
    float* C; int ldc;
    __device__ __forceinline__ void operator()(const f32x4 (&acc)[2][2][4][2], const Unit& u, int wr, int wc, int fr, int fq) const {
        const int row0 = u.pm * BM + wr * 64 + fr, col0 = u.pn * BM + wc * 32 + 4 * fq;
#pragma unroll
        for (int ai = 0; ai < 2; ++ai)
#pragma unroll
            for (int m = 0; m < 4; ++m) { float* rowp = C + (size_t)(row0 + ai * HALF + m * 16) * ldc + col0;
#pragma unroll
                for (int bj = 0; bj < 2; ++bj)
#pragma unroll
                    for (int n = 0; n < 2; ++n) *(f32x4*)(rowp + bj * HALF + n * 16) = acc[ai][bj][m][n]; }
    }
};
struct EpiGateRes {
    static constexpr bool PERM = false, AFTER_DRAIN = false;
    const float* base; float* out; int ldc; const float* gate; int gate_bstride;
    __device__ __forceinline__ void operator()(const f32x4 (&acc)[2][2][4][2], const Unit& u, int wr, int wc, int fr, int fq) const {
        const int row0 = u.pm * BM + wr * 64 + fr, col0 = u.pn * BM + wc * 32 + 4 * fq;
        const float* g = gate + (size_t)(u.pm >> 3) * gate_bstride + col0;
        f32x4 gv[2][2];
#pragma unroll
        for (int bj = 0; bj < 2; ++bj)
#pragma unroll
            for (int n = 0; n < 2; ++n) gv[bj][n] = *(const f32x4*)(g + bj * HALF + n * 16);
#pragma unroll
        for (int ai = 0; ai < 2; ++ai)
#pragma unroll
            for (int m = 0; m < 4; ++m) { const size_t off = (size_t)(row0 + ai * HALF + m * 16) * ldc + col0;
#pragma unroll
                for (int bj = 0; bj < 2; ++bj)
#pragma unroll
                    for (int n = 0; n < 2; ++n) { const f32x4 bs = *(const f32x4*)(base + off + bj * HALF + n * 16);
                        *(f32x4*)(out + off + bj * HALF + n * 16) = bs + gv[bj][n] * acc[ai][bj][m][n]; }
                asm volatile("" ::: "memory"); }
    }
};

template <class Epi, class Sched, bool ALIGN_EPI = false, bool SP2 = false>
__device__ __forceinline__ void gemm_phase(PG8_LAS unsigned char* lds, const Gemm g, const Sched& S, const Epi& E) {
    int tid_ = threadIdx.x; asm volatile("" : "+v"(tid_));
    const int tid = tid_, wid = __builtin_amdgcn_readfirstlane(tid >> 6), lane = tid & 63, wr = wid >> 2, wc = wid & 3, fr = lane & 15, fq = lane >> 4;
    const int K = g.K, nt = K / BK;
    unsigned voffA[2], voffB[2];
#pragma unroll
    for (int i = 0; i < 2; ++i) { int R, C; stage_rc(tid * 16 + i * 8192, R, C); const int Rb = Epi::PERM ? ((R & ~31) + perm32(R & 31)) : R;
        voffA[i] = (unsigned)(R * K + C) * 2u; voffB[i] = (unsigned)(Rb * K + C) * 2u; }
    const size_t kstep = (size_t)(BK * 2);
    const size_t hstep = (size_t)HALF * K * 2;
    const size_t tstep = 2 * hstep;
    const unsigned ldsw = (unsigned)wid * 1024u;
    const int aoff = lds_byte(wr * 64 + fr, fq * 8), boff = lds_byte(wc * 32 + fr, fq * 8);
#define PG8_SA(b, h) (((b) * 2 + (h)) * HTB)
#define PG8_SB(b, h) ((4 + (b) * 2 + (h)) * HTB)
#define PG8_STAGE(bufoff, gbase, voff) do { _Pragma("unroll") for (int _i = 0; _i < 2; ++_i) \
        __builtin_amdgcn_global_load_lds((const unsigned*)((const char*)(gbase) + (voff)[_i]), (PG8_LAS unsigned*)(lds + (bufoff) + ldsw + _i * 8192), 16, 0, 0); } while (0)
#define PG8_LDA(dst, b, h) do { _Pragma("unroll") for (int m = 0; m < 4; ++m) _Pragma("unroll") for (int k = 0; k < 2; ++k) dst[m][k] = *(const PG8_LAS bf16x8*)(lds + PG8_SA(b, h) + aoff + m * 2048 + k * 1024); } while (0)
#define PG8_LDB(dst, b, h) do { _Pragma("unroll") for (int n = 0; n < 2; ++n) _Pragma("unroll") for (int k = 0; k < 2; ++k) dst[n][k] = *(const PG8_LAS bf16x8*)(lds + PG8_SB(b, h) + boff + n * 2048 + k * 1024); } while (0)
#define PG8_MMA(ai, bj, At, Bt) do { __builtin_amdgcn_s_setprio(1); _Pragma("unroll") for (int m = 0; m < 4; ++m) _Pragma("unroll") for (int n = 0; n < 2; ++n) _Pragma("unroll") for (int k = 0; k < 2; ++k) \
        acc[ai][bj][m][n] = __builtin_amdgcn_mfma_f32_16x16x32_bf16(Bt[n][k], At[m][k], acc[ai][bj][m][n], 0, 0, 0); __builtin_amdgcn_s_setprio(0); } while (0)
#define PG8_WAIT_V(n) asm volatile("s_waitcnt vmcnt(" #n ")" ::: "memory")
#define PG8_WAIT_L(n) asm volatile("s_waitcnt lgkmcnt(" #n ")" ::: "memory")
#define PG8_BAR __builtin_amdgcn_s_barrier()
#define PG8_SCHED __builtin_amdgcn_sched_barrier(0)
    Unit cur, nxt; int ui = 0;
    if (!S.next(0, cur)) return;
    f32x4 acc[2][2][4][2];
    float zf = 0.f; asm volatile("" : "+v"(zf));
#pragma unroll
    for (int a = 0; a < 2; ++a)
#pragma unroll
        for (int b = 0; b < 2; ++b)
#pragma unroll
            for (int m = 0; m < 4; ++m)
#pragma unroll
                for (int n = 0; n < 2; ++n) acc[a][b][m][n] = (f32x4){zf, zf, zf, zf};
    bf16x8 At[4][2], B0[2][2], B1[2][2];
    const char* cA = (const char*)g.A + (size_t)cur.pm * tstep; const char* cB = (const char*)g.Bt + (size_t)cur.pn * tstep;
    S.a_ready(cur);
    if constexpr (SP2) {
        PG8_STAGE(PG8_SB(0, 0), cB, voffB); PG8_STAGE(PG8_SB(0, 1), cB + hstep, voffB); PG8_STAGE(PG8_SA(0, 0), cA, voffA); PG8_STAGE(PG8_SA(0, 1), cA + hstep, voffA);
        if (wr == 1) PG8_BAR;
        PG8_WAIT_V(2); PG8_BAR;
        PG8_STAGE(PG8_SB(1, 0), cB + kstep, voffB); PG8_STAGE(PG8_SA(1, 0), cA + kstep, voffA); PG8_STAGE(PG8_SB(1, 1), cB + hstep + kstep, voffB);
        PG8_WAIT_V(6); PG8_BAR;
    } else {
        PG8_STAGE(PG8_SB(0, 0), cB, voffB); PG8_STAGE(PG8_SA(0, 0), cA, voffA); PG8_STAGE(PG8_SB(0, 1), cB + hstep, voffB); PG8_STAGE(PG8_SA(0, 1), cA + hstep, voffA);
        if (wr == 1) PG8_BAR;
        PG8_WAIT_V(4); PG8_BAR;
        PG8_STAGE(PG8_SB(1, 0), cB + kstep, voffB); PG8_STAGE(PG8_SA(1, 0), cA + kstep, voffA); PG8_STAGE(PG8_SB(1, 1), cB + hstep + kstep, voffB);
        PG8_WAIT_V(6); PG8_BAR;
    }
    for (;;) {
        const bool has_next = S.next(ui + 1, nxt);
        const char* nA = has_next ? (const char*)g.A + (size_t)nxt.pm * tstep : cA; const char* nB = has_next ? (const char*)g.Bt + (size_t)nxt.pn * tstep : cB;
        for (int t = 0; t < nt; t += 2) {
            const bool last = (t == nt - 2);
            const char* a1 = cA + (size_t)(t + 1) * kstep;
            const char* a2 = last ? nA : cA + (size_t)(t + 2) * kstep; const char* b2 = last ? nB : cB + (size_t)(t + 2) * kstep;
            const char* a3 = a2 + kstep; const char* b3 = b2 + kstep;
            if (last && has_next) S.a_ready(nxt);
            if constexpr (SP2) {
            PG8_LDB(B0, 0, 0); PG8_LDB(B1, 0, 1); PG8_SCHED; PG8_LDA(At, 0, 0); PG8_STAGE(PG8_SA(1, 1), a1 + hstep, voffA);
            PG8_WAIT_V(8); PG8_WAIT_L(0); PG8_BAR; PG8_MMA(0, 0, At, B0); PG8_MMA(0, 1, At, B1); PG8_BAR; PG8_SCHED;
            PG8_LDA(At, 0, 1); PG8_STAGE(PG8_SB(0, 0), b2, voffB); PG8_STAGE(PG8_SB(0, 1), b2 + hstep, voffB); PG8_STAGE(PG8_SA(0, 0), a2, voffA);
            PG8_WAIT_V(8); PG8_WAIT_L(0); PG8_BAR; PG8_MMA(1, 0, At, B0); PG8_MMA(1, 1, At, B1); PG8_BAR; PG8_SCHED;
            PG8_LDB(B0, 1, 0); PG8_LDB(B1, 1, 1); PG8_SCHED; PG8_LDA(At, 1, 0); PG8_STAGE(PG8_SA(0, 1), a2 + hstep, voffA);
            PG8_WAIT_V(8); PG8_WAIT_L(0); PG8_BAR; PG8_MMA(0, 0, At, B0); PG8_MMA(0, 1, At, B1); PG8_BAR; PG8_SCHED;
            PG8_LDA(At, 1, 1); PG8_STAGE(PG8_SB(1, 0), b3, voffB); PG8_STAGE(PG8_SB(1, 1), b3 + hstep, voffB); PG8_STAGE(PG8_SA(1, 0), a3, voffA);
            PG8_WAIT_V(8); PG8_WAIT_L(0); PG8_BAR; PG8_MMA(1, 0, At, B0); PG8_MMA(1, 1, At, B1); PG8_BAR; PG8_SCHED;
            } else {
            PG8_LDB(B0, 0, 0); PG8_SCHED; PG8_LDA(At, 0, 0); PG8_STAGE(PG8_SA(1, 1), a1 + hstep, voffA);
            PG8_WAIT_L(8); PG8_BAR; PG8_WAIT_L(0); PG8_MMA(0, 0, At, B0); PG8_BAR; PG8_SCHED;
            PG8_LDB(B1, 0, 1); PG8_STAGE(PG8_SB(0, 0), b2, voffB);
            PG8_BAR; PG8_WAIT_L(0); PG8_MMA(0, 1, At, B1); PG8_BAR;
            PG8_LDA(At, 0, 1); PG8_STAGE(PG8_SA(0, 0), a2, voffA);
            PG8_BAR; PG8_WAIT_L(0); PG8_MMA(1, 0, At, B0); PG8_BAR; PG8_SCHED;
            PG8_STAGE(PG8_SB(0, 1), b2 + hstep, voffB);
            PG8_WAIT_V(6); PG8_BAR; PG8_MMA(1, 1, At, B1); PG8_BAR;
            PG8_LDB(B0, 1, 0); PG8_SCHED; PG8_LDA(At, 1, 0); PG8_STAGE(PG8_SA(0, 1), a2 + hstep, voffA);
            PG8_WAIT_L(8); PG8_BAR; PG8_WAIT_L(0); PG8_MMA(0, 0, At, B0); PG8_BAR; PG8_SCHED;
            PG8_LDB(B1, 1, 1); PG8_STAGE(PG8_SB(1, 0), b3, voffB);
            PG8_BAR; PG8_WAIT_L(0); PG8_MMA(0, 1, At, B1); PG8_BAR;
            PG8_LDA(At, 1, 1); PG8_STAGE(PG8_SA(1, 0), a3, voffA);
            PG8_BAR; PG8_WAIT_L(0); PG8_MMA(1, 0, At, B0); PG8_BAR; PG8_SCHED;
            PG8_STAGE(PG8_SB(1, 1), b3 + hstep, voffB);
            PG8_WAIT_V(6); PG8_BAR; PG8_MMA(1, 1, At, B1); PG8_BAR;
            }
        }
        if constexpr (ALIGN_EPI) { if (wr == 0) PG8_BAR; }
        if constexpr (!Epi::AFTER_DRAIN) { E(acc, cur, wr, wc, fr, fq); S.done(cur); }
        if (!has_next) break;
#pragma unroll
        for (int a = 0; a < 2; ++a)
#pragma unroll
            for (int b = 0; b < 2; ++b)
#pragma unroll
                for (int m = 0; m < 4; ++m)
#pragma unroll
                    for (int n = 0; n < 2; ++n) acc[a][b][m][n] = (f32x4){zf, zf, zf, zf};
        cur = nxt; cA = nA; cB = nB; ++ui;
        if constexpr (ALIGN_EPI) { if (wr == 1) PG8_BAR; }
    }
    PG8_WAIT_V(0);
    if constexpr (!ALIGN_EPI) { if (wr == 0) PG8_BAR; }
    PG8_BAR;
#undef PG8_SA
#undef PG8_SB
#undef PG8_STAGE
#undef PG8_LDA
#undef PG8_LDB
#undef PG8_MMA
#undef PG8_WAIT_V
#undef PG8_WAIT_L
#undef PG8_BAR
#undef PG8_SCHED
}
}

constexpr int NB = 4, SEQ = 2048, D = 2048, M = NB * SEQ, NH = 16, HD = 128, FF = 8192, DEPTH = 4, MODW = 6 * D;
constexpr int NQKV_A = 3 * D, NQKV_B = 9 * D;
constexpr int MLA_QR = 512, MLA_KVR = 512, MLA_ROPE = 64, MLA_IN = 1088, MLA_IN_PAD = 1280, MLA_QW = NH * 192, MLA_KVW = NH * 256;
constexpr float EPS = 1e-6f;
constexpr int NWAVES = 8;

constexpr size_t MiB = 1u << 20;
constexpr size_t WS_CTL = 0, CTL_ZERO_BYTES = 1 * MiB;
constexpr size_t WS_MOD = 1 * MiB;
constexpr size_t WS_WA_QKV = 2 * MiB;
constexpr size_t WS_WA_O = 50 * MiB;
constexpr size_t WS_WB_QKV = 66 * MiB;
constexpr size_t WS_WB_O = 138 * MiB;
constexpr size_t WS_WC_IN = 146 * MiB;
constexpr size_t WS_WC_UQ = 151 * MiB;
constexpr size_t WS_WC_UKV = 154 * MiB;
constexpr size_t WS_WC_O = 158 * MiB;
constexpr size_t WS_WUP = 166 * MiB;
constexpr size_t WS_WDN = 294 * MiB;
constexpr size_t WS_H = 422 * MiB;
constexpr size_t WS_U = 486 * MiB;
constexpr size_t WS_O = 518 * MiB;
constexpr size_t WS_QKV = 550 * MiB;
constexpr size_t WS_HID = 838 * MiB;
constexpr size_t WS_END = 966 * MiB;
constexpr size_t WS_C_HCAT = WS_QKV, WS_C_CQ = WS_QKV + 40 * MiB, WS_C_CKV = WS_QKV + 48 * MiB, WS_C_KR = WS_QKV + 56 * MiB, WS_C_Q = WS_QKV + 64 * MiB, WS_C_KV = WS_QKV + 112 * MiB;
constexpr int CW_BAR = 4096;

constexpr int RING_BYTES = 131072;
constexpr int LDSCTL_OFF = RING_BYTES, MISC_OFF = LDSCTL_OFF + 320;
constexpr int LDS_BYTES = 147456;

#define GAS __attribute__((address_space(1)))
#define LAS __attribute__((address_space(3)))
typedef unsigned short bf16;
typedef unsigned v4u __attribute__((ext_vector_type(4)));
typedef unsigned v2u __attribute__((ext_vector_type(2)));
typedef float f32x4 __attribute__((ext_vector_type(4)));
#define LDS_WAIT() asm volatile("s_waitcnt lgkmcnt(0)" ::: "memory")
#define VM_WAIT() asm volatile("s_waitcnt vmcnt(0)" ::: "memory")
__device__ __forceinline__ unsigned f2bf(float f) { unsigned u = __builtin_bit_cast(unsigned, f); return (u + 0x7fffu + ((u >> 16) & 1u)) >> 16; }
__device__ __forceinline__ unsigned pk2(float lo, float hi) { return f2bf(lo) | (f2bf(hi) << 16); }
__device__ __forceinline__ float bflo(unsigned w) { return __builtin_bit_cast(float, w << 16); }
__device__ __forceinline__ float bfhi(unsigned w) { return __builtin_bit_cast(float, w & 0xffff0000u); }
__device__ __forceinline__ float bf1(bf16 h) { return __builtin_bit_cast(float, ((unsigned)h) << 16); }

#define XB_TMO      128
#define XB_XCNT(j)  (256  + 64 * (j))
#define XB_XSUB(j)  (1280 + 64 * (j))
#define XB_XGEN(j)  (2304 + 64 * (j))
#define XB_TOP      3328
#define XB_TOPGEN   3392
#define XCD_BAR_WORDS 3456
#define XB_SPIN_CAP (1u << 18)

__device__ __forceinline__ unsigned xb_ld(unsigned* p)              { return __hip_atomic_load(p, __ATOMIC_RELAXED, __HIP_MEMORY_SCOPE_AGENT); }
__device__ __forceinline__ unsigned xb_add(unsigned* p, unsigned v) { return __hip_atomic_fetch_add(p, v, __ATOMIC_RELAXED, __HIP_MEMORY_SCOPE_AGENT); }
__device__ __forceinline__ unsigned xb_xcc_id() { return (unsigned)__builtin_amdgcn_s_getreg((3 << 11) | 20) & 0xFu; }
#define XB_SPIN(cond, bar) do { unsigned _sp = 0; while (cond) { __builtin_amdgcn_s_sleep(1); \
    if ((++_sp & 255u) == 0u) { if (xb_ld(&(bar)[XB_TMO])) break; if (_sp > XB_SPIN_CAP) { atomicAdd(&(bar)[XB_TMO], 1u); break; } } } } while (0)

struct XcdBarrier {
    unsigned* bar; unsigned x;
    volatile LAS unsigned* st;
};
__device__ __forceinline__ XcdBarrier xcd_barrier_post(unsigned* bar, volatile LAS unsigned* st) {
    XcdBarrier b; b.bar = bar; b.x = xb_xcc_id(); b.st = st;
    if (threadIdx.x == 0) (void)xb_add(&bar[XB_XCNT(b.x)], 1u);
    return b;
}
__device__ __forceinline__ void xcd_barrier_complete(unsigned* bar, unsigned x, unsigned& nloc, unsigned& nx) {
    const unsigned G = gridDim.x * gridDim.y * gridDim.z;
    unsigned sum, cnt, mine, sp = 0u;
    for (;;) {
        sum = 0u; cnt = 0u; mine = 0u;
#pragma unroll
        for (unsigned j = 0; j < 16; ++j) { const unsigned c = xb_ld(&bar[XB_XCNT(j)]); sum += c; cnt += (c > 0u) ? 1u : 0u; mine = (j == x) ? c : mine; }
        if (sum == G) break;
        __builtin_amdgcn_s_sleep(1);
        if ((++sp & 255u) == 0u) { if (xb_ld(&bar[XB_TMO])) break; if (sp > XB_SPIN_CAP) { atomicAdd(&bar[XB_TMO], 1u); break; } }
    }
    nloc = mine > 0u ? mine : 1u; nx = cnt > 0u ? cnt : 1u;
}
__device__ __forceinline__ void xcd_barrier(const XcdBarrier& b) {
    asm volatile("s_waitcnt vmcnt(0)" ::: "memory");
    __syncthreads();
    if (threadIdx.x == 0) {
        unsigned* bar = b.bar;
        __builtin_amdgcn_s_waitcnt(0);
        unsigned nloc = b.st[0], nx = b.st[1];
        if (nloc == 0u) { xcd_barrier_complete(bar, b.x, nloc, nx); b.st[0] = nloc; b.st[1] = nx; }
        const unsigned old = xb_add(&bar[XB_XSUB(b.x)], 1u);
        const unsigned gen = old / nloc;
        if (old + 1u == (gen + 1u) * nloc) {
            __builtin_amdgcn_fence(__ATOMIC_RELEASE, "agent");
            asm volatile("s_waitcnt vmcnt(0)" ::: "memory");
            const unsigned og = xb_add(&bar[XB_TOP], 1u);
            const unsigned tg = og / nx;
            if (og + 1u == (tg + 1u) * nx) xb_add(&bar[XB_TOPGEN], 1u);
            else XB_SPIN(xb_ld(&bar[XB_TOPGEN]) == tg, bar);
            __builtin_amdgcn_fence(__ATOMIC_ACQUIRE, "agent");
            xb_add(&bar[XB_XGEN(b.x)], 1u);
            asm volatile("s_waitcnt vmcnt(0)" ::: "memory");
        } else {
            XB_SPIN(xb_ld(&bar[XB_XGEN(b.x)]) == gen, bar);
            __builtin_amdgcn_fence(__ATOMIC_ACQUIRE, "agent");
            asm volatile("s_waitcnt vmcnt(0)" ::: "memory");
        }
    }
    __syncthreads();
}

__device__ __forceinline__ float wave_sum(float v) {
#pragma unroll
    for (int o = 1; o < 64; o <<= 1) v += __shfl_xor(v, o);
    return v;
}
__device__ __forceinline__ float wave_max(float v) {
#pragma unroll
    for (int o = 1; o < 64; o <<= 1) v = fmaxf(v, __shfl_xor(v, o));
    return v;
}
__device__ __forceinline__ void sincos_rev(float a, float& sn, float& cs) {
    float r = a * 0.15915494309189535f; r -= floorf(r);
    sn = __builtin_amdgcn_sinf(r); cs = __builtin_amdgcn_cosf(r);
}
__device__ __forceinline__ float rope_inv(int i, int half) { return exp2f(-(float)i * (13.287712379549449f / (float)half)); }

__device__ __forceinline__ void p0_transpose_item(const float* W, int K, int N, bf16* WT, LAS float* scr, int item, int lane) {
    const int nblk = N / 32, kb = item / nblk, nb = item % nblk, k0 = 64 * kb, n0 = 32 * nb;
#pragma unroll 8
    for (int i = 0; i < 32; ++i) { const int kk = 2 * i + (lane >> 5); scr[kk * 33 + (lane & 31)] = W[(size_t)(k0 + kk) * N + n0 + (lane & 31)]; }
    LDS_WAIT(); asm volatile("" ::: "memory");
    const int c = lane & 7;
#pragma unroll
    for (int j = 0; j < 4; ++j) { const int n = (lane >> 3) + 8 * j; const LAS float* s = scr + (8 * c) * 33 + n;
        v4u o; o.x = pk2(s[0 * 33], s[1 * 33]); o.y = pk2(s[2 * 33], s[3 * 33]); o.z = pk2(s[4 * 33], s[5 * 33]); o.w = pk2(s[6 * 33], s[7 * 33]);
        *(GAS v4u*)(WT + (size_t)(n0 + n) * K + k0 + 8 * c) = o; }
    LDS_WAIT(); asm volatile("" ::: "memory");
}


typedef short bf16x8 __attribute__((ext_vector_type(8)));
typedef short s16x4 __attribute__((ext_vector_type(4)));
__device__ __forceinline__ s16x4 tr_read_b64(unsigned addr) { s16x4 r; asm volatile("ds_read_b64_tr_b16 %0, %1" : "=v"(r) : "v"(addr) : "memory"); return r; }
__device__ __forceinline__ unsigned vimg_off(int row, int ch) { return 256u * row + 16u * (ch ^ (((row & 3) << 2) | ((row >> 2) & 3))); }
constexpr float LOG2E = 1.4426950408889634f;

template <int NT, class Map>
__device__ __forceinline__ void attn16_unit(const unsigned wl, const bf16* __restrict__ Qg, const bf16* __restrict__ Kg, const bf16* __restrict__ Vg, const int ld, const Map& mp,
                                            const int lane, const float scale_log2, f32x4 (&acc)[8], float& mx_out, float& sum_out) {
    const int qi = lane & 15, kg = lane >> 4;
    bf16x8 qf[4];
    { const bf16* qp = Qg + (size_t)mp.qtok(qi) * ld + 8 * kg;
#pragma unroll
      for (int ks = 0; ks < 4; ++ks) qf[ks] = *(const bf16x8*)(qp + 32 * ks); }
    f32x4 sc[NT];
    bf16x8 kf[2][4];
#define A16_LOADK(t, dst) do { const bf16* kp_ = Kg + (size_t)mp.ktok((t), qi) * ld + 8 * kg; _Pragma("unroll") for (int ks = 0; ks < 4; ++ks) dst[ks] = *(const bf16x8*)(kp_ + 32 * ks); } while (0)
    A16_LOADK(0, kf[0]);
#pragma unroll
    for (int t = 0; t < NT; ++t) {
        if (t + 1 < NT) A16_LOADK(t + 1, kf[(t + 1) & 1]);
        f32x4 a = (f32x4){0.f, 0.f, 0.f, 0.f};
#pragma unroll
        for (int ks = 0; ks < 4; ++ks) a = __builtin_amdgcn_mfma_f32_16x16x32_bf16(kf[t & 1][ks], qf[ks], a, 0, 0, 0);
#pragma unroll
        for (int j = 0; j < 4; ++j) sc[t][j] = mp.score(t, 4 * kg + j, qi, a[j] * scale_log2);
        __builtin_amdgcn_sched_barrier(0);
    }
#undef A16_LOADK
    float mx = -1e30f;
#pragma unroll
    for (int t = 0; t < NT; ++t)
#pragma unroll
        for (int j = 0; j < 4; ++j) mx = fmaxf(mx, sc[t][j]);
    mx = fmaxf(mx, __shfl_xor(mx, 16)); mx = fmaxf(mx, __shfl_xor(mx, 32));
    float sum = 0.f;
#pragma unroll
    for (int t = 0; t < NT; ++t)
#pragma unroll
        for (int j = 0; j < 4; ++j) { sc[t][j] = __builtin_amdgcn_exp2f(sc[t][j] - mx); sum += sc[t][j]; }
    sum += __shfl_xor(sum, 16); sum += __shfl_xor(sum, 32);
    mx_out = mx; sum_out = sum;
    bf16x8 pbf[NT / 2];
#pragma unroll
    for (int s = 0; s < NT / 2; ++s) { const f32x4 p0 = sc[2 * s], p1 = sc[2 * s + 1]; v4u w; w.x = pk2(p0[0], p0[1]); w.y = pk2(p0[2], p0[3]); w.z = pk2(p1[0], p1[1]); w.w = pk2(p1[2], p1[3]); pbf[s] = __builtin_bit_cast(bf16x8, w); }
#pragma unroll
    for (int mt = 0; mt < 8; ++mt) acc[mt] = (f32x4){0.f, 0.f, 0.f, 0.f};
    v4u vst[8];
#define A16_LOADV(s) do { _Pragma("unroll") for (int i = 0; i < 8; ++i) { const int row_ = kg + 4 * i; \
        vst[i] = *(const v4u*)(Vg + (size_t)mp.ktok(2 * (s) + (row_ >> 4), row_ & 15) * ld + 8 * qi); } } while (0)
    A16_LOADV(0);
    const int trq = (lane & 15) >> 2, trp = lane & 3;
#pragma unroll
    for (int s = 0; s < NT / 2; ++s) {
        const unsigned buf = wl + (unsigned)(s & 1) * 8192u;
#pragma unroll
        for (int i = 0; i < 8; ++i) { const int row_ = kg + 4 * i; *(LAS v4u*)(size_t)(buf + vimg_off(row_, qi)) = vst[i]; }
        __builtin_amdgcn_sched_barrier(0);
        if (s + 1 < NT / 2) A16_LOADV(s + 1);
        __builtin_amdgcn_sched_barrier(0);
#pragma unroll
        for (int mh = 0; mh < 2; ++mh) {
            s16x4 lo[4], hi[4];
#pragma unroll
            for (int m4 = 0; m4 < 4; ++m4) { const int mt = mh * 4 + m4; const int r0_ = 4 * kg + trq, r1_ = 16 + 4 * kg + trq, ch_ = 2 * mt + (trp >> 1);
                lo[m4] = tr_read_b64(buf + vimg_off(r0_, ch_) + 8u * (trp & 1)); hi[m4] = tr_read_b64(buf + vimg_off(r1_, ch_) + 8u * (trp & 1)); }
            asm volatile("s_waitcnt lgkmcnt(0)" ::: "memory"); __builtin_amdgcn_sched_barrier(0);
#pragma unroll
            for (int m4 = 0; m4 < 4; ++m4) { const int mt = mh * 4 + m4; const bf16x8 va = (bf16x8){lo[m4][0], lo[m4][1], lo[m4][2], lo[m4][3], hi[m4][0], hi[m4][1], hi[m4][2], hi[m4][3]};
                acc[mt] = __builtin_amdgcn_mfma_f32_16x16x32_bf16(va, pbf[s], acc[mt], 0, 0, 0); }
        }
        __builtin_amdgcn_sched_barrier(0);
    }
#undef A16_LOADV
}

struct NAMap {
    int b, r, r0, cb, cs; const float* rpb_h;
    __device__ __forceinline__ int qtok(int q) const { return b * SEQ + r * 64 + 16 * cb + q; }
    __device__ __forceinline__ int ktok(int t, int j) const { return b * SEQ + (r0 + (t >> 1)) * 64 + cs + 16 * (t & 1) + j; }
    __device__ __forceinline__ float score(int t, int kj, int q, float s) const {
        const int kc = cs + 16 * (t & 1) + kj, c = 16 * cb + q, ws = min(max(c - 8, 0), 48);
        const bool valid = (kc >= ws) && (kc < ws + 16);
        const int dc = min(max(kc - c + 15, 0), 30);
        const float bias = rpb_h[(r0 + (t >> 1) - r + 7) * 31 + dc];
        return valid ? s + bias * LOG2E : -1e30f;
    }
};
struct DSWMap {
    int b, dil, rho, m0, Lc;
    __device__ __forceinline__ int qtok(int q) const { return b * SEQ + (m0 + q) * dil + rho; }
    __device__ __forceinline__ int ktok(int t, int j) const { const int m = min(max(m0 - 64 + 16 * t + j, 0), Lc - 1); return b * SEQ + m * dil + rho; }
    __device__ __forceinline__ float score(int t, int kj, int q, float s) const {
        const int m = m0 - 64 + 16 * t + kj, d = m - (m0 + q);
        const bool valid = (m >= 0) && (m < Lc) && (d >= -64) && (d <= 64);
        return valid ? s : -1e30f;
    }
};


namespace mla {
using f32x16 = __attribute__((ext_vector_type(16))) float;
constexpr int KVBLK = 64, QBLK = 32;
constexpr float SCALE = 0.07216878364870323f;
constexpr float THR = 8.f;
constexpr int KROW = 400;
constexpr int SHM_V = KVBLK * 128 * 2, SHM_K = KVBLK * KROW;
constexpr int QR_PITCH = 144;
constexpr int LDS_BYTES_MLA = 2 * SHM_V + 2 * SHM_K + 8 * 64 * 4 + 8 * 32 * QR_PITCH;
#define MLA_KSWZ(row, colB) ((row) * mla::KROW + (colB))
#define MLA_SBAR() __builtin_amdgcn_sched_barrier(0)
__device__ __forceinline__ int crow(int r, int hi) { return (r & 3) + 8 * (r >> 2) + 4 * hi; }
__device__ __forceinline__ unsigned cvtpk(float lo, float hi) { unsigned r; asm volatile("v_cvt_pk_bf16_f32 %0, %1, %2" : "=v"(r) : "v"(lo), "v"(hi)); return r; }
__device__ __forceinline__ void partialSM(f32x16& p0, f32x16& p1, float& m_reg, float& mn, float& alpha) {
  constexpr float C = SCALE * 1.4426950408889634f;
  float pmax = p0[0];
#pragma unroll
  for (int r = 1; r < 16; ++r) pmax = fmaxf(pmax, p0[r]);
#pragma unroll
  for (int r = 0; r < 16; ++r) pmax = fmaxf(pmax, p1[r]);
  { auto rr = __builtin_amdgcn_permlane32_swap(__float_as_uint(pmax), __float_as_uint(pmax), false, false);
    pmax = fmaxf(__uint_as_float(rr[0]), __uint_as_float(rr[1])); }
  if (__builtin_expect(__all(pmax - m_reg <= THR / SCALE), 1)) { mn = m_reg; alpha = 1.f; }
  else { mn = fmaxf(m_reg, pmax); alpha = __builtin_amdgcn_exp2f((m_reg - mn) * C); m_reg = mn; }
  float mnC = -mn * C;
#pragma unroll
  for (int r = 0; r < 16; ++r) p0[r] = fmaf(p0[r], C, mnC);
#pragma unroll
  for (int r = 0; r < 16; ++r) p1[r] = fmaf(p1[r], C, mnC);
#pragma unroll
  for (int r = 0; r < 16; ++r) p0[r] = __builtin_amdgcn_exp2f(p0[r]);
}
__device__ __forceinline__ void finishSM(f32x16& p0, f32x16& p1, float alpha, float& l_reg, bf16x8& pa0, bf16x8& pa1, bf16x8& pa2, bf16x8& pa3) {
#pragma unroll
  for (int r = 0; r < 16; ++r) p1[r] = __builtin_amdgcn_exp2f(p1[r]);
  float ps = 0;
#pragma unroll
  for (int r = 0; r < 16; ++r) ps += p0[r];
#pragma unroll
  for (int r = 0; r < 16; ++r) ps += p1[r];
  { auto rr = __builtin_amdgcn_permlane32_swap(__float_as_uint(ps), __float_as_uint(ps), false, false);
    ps = __uint_as_float(rr[0]) + __uint_as_float(rr[1]); }
  l_reg = l_reg * alpha + ps;
#define MLA_PK4(P, BASE, OUT) do { unsigned a0 = cvtpk(P[BASE + 0], P[BASE + 1]), a1 = cvtpk(P[BASE + 2], P[BASE + 3]);   \
    unsigned b0 = cvtpk(P[BASE + 4], P[BASE + 5]), b1 = cvtpk(P[BASE + 6], P[BASE + 7]);                              \
    auto r0 = __builtin_amdgcn_permlane32_swap(a0, b0, false, false); auto r1 = __builtin_amdgcn_permlane32_swap(a1, b1, false, false); \
    v4u w = {r0[0], r1[0], r0[1], r1[1]}; OUT = __builtin_bit_cast(bf16x8, w); } while (0)
  MLA_PK4(p0, 0, pa0); MLA_PK4(p0, 8, pa1); MLA_PK4(p1, 0, pa2); MLA_PK4(p1, 8, pa3);
#undef MLA_PK4
}
__device__ __forceinline__ void qkt(f32x16& p0, f32x16& p1, const unsigned Ks, const bf16x8* qr, const unsigned qrl, int r32, int hi) {
  p0 = f32x16{}; p1 = f32x16{};
#pragma unroll
  for (int dg = 0; dg < 3; ++dg) {
#pragma unroll
    for (int d4 = 0; d4 < 4; ++d4) { const int d0 = dg * 4 + d4;
      const bf16x8 b0 = *(const LAS bf16x8*)(size_t)(Ks + (unsigned)(r32 * KROW + hi * 16) + (unsigned)(d0 * 32));
      const bf16x8 b1 = *(const LAS bf16x8*)(size_t)(Ks + (unsigned)(r32 * KROW + hi * 16) + (unsigned)(32 * KROW + d0 * 32));
      const bf16x8 qv = (dg < 2) ? qr[d0 & 7] : *(const LAS bf16x8*)(size_t)(qrl + (unsigned)(d4 * 32));
      p0 = __builtin_amdgcn_mfma_f32_32x32x16_bf16(b0, qv, p0, 0, 0, 0);
      p1 = __builtin_amdgcn_mfma_f32_32x32x16_bf16(b1, qv, p1, 0, 0, 0); }
    MLA_SBAR(); }
}
__device__ __forceinline__ int v_st(int k, int c) { const int kk = (k & ~0xC) | ((k & 4) << 1) | ((k & 8) >> 1); return ((kk >> 3) * 4 + (c >> 5)) * 512 + ((kk & 7) * 32 + (c & 31)) * 2; }
__device__ __forceinline__ int v_rd_base(int lane) { return ((lane & 3) << 3) | (((lane >> 2) & 3) << 6) | (((lane >> 4) & 1) << 5) | (((lane >> 5) & 1) << 8); }
constexpr int v_rd_off(int d0, int ks, int half) { return d0 * 512 + ks * 4096 + half * 2048; }
template <int OFF> __device__ __forceinline__ s16x4 tr_read(int vb) {
  s16x4 r; asm volatile("ds_read_b64_tr_b16 %0, %1 offset:%2" : "=&v"(r) : "v"(vb), "i"(OFF) : "memory"); return r;
}
template <int D0> __device__ __forceinline__ void pv_one(f32x16& od, int vb, bf16x8 pa0, bf16x8 pa1, bf16x8 pa2, bf16x8 pa3) {
  const s16x4 l0 = tr_read<v_rd_off(D0, 0, 0)>(vb), h0 = tr_read<v_rd_off(D0, 0, 1)>(vb), l1 = tr_read<v_rd_off(D0, 1, 0)>(vb), h1 = tr_read<v_rd_off(D0, 1, 1)>(vb);
  const s16x4 l2 = tr_read<v_rd_off(D0, 2, 0)>(vb), h2 = tr_read<v_rd_off(D0, 2, 1)>(vb), l3 = tr_read<v_rd_off(D0, 3, 0)>(vb), h3 = tr_read<v_rd_off(D0, 3, 1)>(vb);
  asm volatile("s_waitcnt lgkmcnt(0)" ::: "memory"); MLA_SBAR();
#define MLA_PK(L, H) (bf16x8){L[0], L[1], L[2], L[3], H[0], H[1], H[2], H[3]}
  od = __builtin_amdgcn_mfma_f32_32x32x16_bf16(pa0, MLA_PK(l0, h0), od, 0, 0, 0);
  od = __builtin_amdgcn_mfma_f32_32x32x16_bf16(pa1, MLA_PK(l1, h1), od, 0, 0, 0);
  od = __builtin_amdgcn_mfma_f32_32x32x16_bf16(pa2, MLA_PK(l2, h2), od, 0, 0, 0);
  od = __builtin_amdgcn_mfma_f32_32x32x16_bf16(pa3, MLA_PK(l3, h3), od, 0, 0, 0);
#undef MLA_PK
}
__device__ __forceinline__ void pv_d0(f32x16* o, int vb, bf16x8 pa0, bf16x8 pa1, bf16x8 pa2, bf16x8 pa3) {
  pv_one<0>(o[0], vb, pa0, pa1, pa2, pa3); pv_one<1>(o[1], vb, pa0, pa1, pa2, pa3); pv_one<2>(o[2], vb, pa0, pa1, pa2, pa3); pv_one<3>(o[3], vb, pa0, pa1, pa2, pa3);
}
__device__ __forceinline__ void attn_body(const bf16* __restrict__ Qb, const int ldq, const bf16* __restrict__ Kn, const bf16* __restrict__ Vh, const int ldkv, const bf16* __restrict__ Kr,
                                          bf16* __restrict__ Ob, const int ldo, const int seq, const unsigned lds, const int tid) {
  const int wid = tid >> 6, lane = tid & 63, r32 = lane & 31, hi = lane >> 5;
  const unsigned V_lds = lds, K_lds = lds + 2 * SHM_V;
  LAS float* ws = (LAS float*)(size_t)(lds + 2 * SHM_V + 2 * SHM_K) + wid * 64; LAS float* li_l = ws; LAS float* al_l = ws + 32;
  float m_reg = -1e30f, l_reg = 0; f32x16 o[4] = {}; bf16x8 qr[8];
  const bf16* Qw = Qb + (size_t)(wid * QBLK + r32) * ldq + hi * 8;
#pragma unroll
  for (int d0 = 0; d0 < 8; ++d0) qr[d0] = *(const bf16x8*)(Qw + d0 * 16);
  const unsigned qrl = lds + 2 * SHM_V + 2 * SHM_K + 8 * 64 * 4 + (unsigned)(wid * 32 * QR_PITCH + r32 * QR_PITCH + hi * 16);
#pragma unroll
  for (int d4 = 0; d4 < 4; ++d4) *(LAS bf16x8*)(size_t)(qrl + (unsigned)(d4 * 32)) = *(const bf16x8*)(Qw + (8 + d4) * 16);
  const int sr = tid >> 4, sc = (tid & 15) * 8, vst0 = v_st(sr, sc), vst1 = v_st(32 + sr, sc);
  const int rr = tid >> 3, rc = (tid & 7) * 8;
  const int vb0 = (int)V_lds + v_rd_base(lane);
  bf16x8 vs0, vs1, ks0, ks1, kr0;
  const unsigned goff0 = (unsigned)(sr * ldkv + sc), goff1 = (unsigned)((32 + sr) * ldkv + sc), goffr = (unsigned)(rr * 64 + rc);
#define MLA_SLOAD(k0) do { const bf16* vt_ = Vh + (size_t)(k0) * ldkv; const bf16* kt_ = Kn + (size_t)(k0) * ldkv; const bf16* rt_ = Kr + (size_t)(k0) * 64; \
    vs0 = *(const bf16x8*)(vt_ + goff0); vs1 = *(const bf16x8*)(vt_ + goff1); ks0 = *(const bf16x8*)(kt_ + goff0); ks1 = *(const bf16x8*)(kt_ + goff1); kr0 = *(const bf16x8*)(rt_ + goffr); } while (0)
#define MLA_SWRITE(b) do { *(LAS bf16x8*)(size_t)(V_lds + (b) * SHM_V + vst0) = vs0; *(LAS bf16x8*)(size_t)(V_lds + (b) * SHM_V + vst1) = vs1; const int kc = sc * 2; \
    *(LAS bf16x8*)(size_t)(K_lds + (b) * SHM_K + MLA_KSWZ(sr, kc)) = ks0; *(LAS bf16x8*)(size_t)(K_lds + (b) * SHM_K + MLA_KSWZ(32 + sr, kc)) = ks1; \
    *(LAS bf16x8*)(size_t)(K_lds + (b) * SHM_K + MLA_KSWZ(rr, 256 + rc * 2)) = kr0; } while (0)
#define MLA_SWAIT() asm volatile("s_waitcnt vmcnt(0)" ::: "memory")
#define MLA_RESC(a) do { if (__any((a) < 1.f)) { if (hi == 0) al_l[r32] = (a); asm volatile("s_waitcnt lgkmcnt(0)" ::: "memory"); \
    _Pragma("unroll") for (int d = 0; d < 4; ++d) _Pragma("unroll") for (int r = 0; r < 16; ++r) o[d][r] *= al_l[crow(r, hi)]; } } while (0)
  f32x16 pA0, pA1, pB0, pB1; float mnA, mnB, alA, alB; bf16x8 pa0, pa1, pa2, pa3; const int NT = seq / KVBLK;
  MLA_SLOAD(0); MLA_SWAIT(); MLA_SWRITE(0); __syncthreads();
  qkt(pA0, pA1, K_lds, qr, qrl, r32, hi); partialSM(pA0, pA1, m_reg, mnA, alA);
  MLA_SLOAD(KVBLK);
  MLA_SWAIT(); MLA_SWRITE(1); __syncthreads();
  for (int j = 1; j + 1 < NT; j += 2) {
    MLA_SBAR(); qkt(pB0, pB1, K_lds + SHM_K, qr, qrl, r32, hi);
    finishSM(pA0, pA1, alA, l_reg, pa0, pa1, pa2, pa3); MLA_SBAR();
    MLA_SLOAD((j + 1) * KVBLK); MLA_SBAR();
    pv_d0(o, vb0, pa0, pa1, pa2, pa3); partialSM(pB0, pB1, m_reg, mnB, alB);
    __syncthreads(); MLA_SWAIT(); MLA_SWRITE(0);
    MLA_RESC(alB); __syncthreads();
    MLA_SBAR(); qkt(pA0, pA1, K_lds, qr, qrl, r32, hi);
    finishSM(pB0, pB1, alB, l_reg, pa0, pa1, pa2, pa3); MLA_SBAR();
    MLA_SLOAD((j + 2) * KVBLK); MLA_SBAR();
    pv_d0(o, vb0 + SHM_V, pa0, pa1, pa2, pa3); partialSM(pA0, pA1, m_reg, mnA, alA);
    __syncthreads(); MLA_SWAIT(); MLA_SWRITE(1);
    MLA_RESC(alA); __syncthreads();
  }
  MLA_SBAR(); qkt(pB0, pB1, K_lds + SHM_K, qr, qrl, r32, hi);
  finishSM(pA0, pA1, alA, l_reg, pa0, pa1, pa2, pa3); MLA_SBAR();
  pv_d0(o, vb0, pa0, pa1, pa2, pa3); partialSM(pB0, pB1, m_reg, mnB, alB);
  __syncthreads(); MLA_RESC(alB);
  finishSM(pB0, pB1, alB, l_reg, pa0, pa1, pa2, pa3); MLA_SBAR();
  pv_d0(o, vb0 + SHM_V, pa0, pa1, pa2, pa3);
  if (hi == 0) li_l[r32] = l_reg; asm volatile("s_waitcnt lgkmcnt(0)" ::: "memory");
  float rli[16];
#pragma unroll
  for (int r = 0; r < 16; ++r) rli[r] = __builtin_amdgcn_rcpf(li_l[crow(r, hi)]);
  bf16* Ow = Ob + (size_t)(wid * QBLK) * ldo;
#pragma unroll
  for (int r = 0; r < 16; ++r) { const int orow = crow(r, hi);
#pragma unroll
    for (int d0 = 0; d0 < 4; ++d0) Ow[(size_t)orow * ldo + d0 * 32 + r32] = (bf16)f2bf(o[d0][r] * rli[r]); }
  __syncthreads();
#undef MLA_SLOAD
#undef MLA_SWRITE
#undef MLA_SWAIT
#undef MLA_RESC
}
}

struct Args { const float* in[20]; float* out; unsigned char* ws; int ph_lo, ph_hi; };

#define PHASE_LOCALS unsigned char* wsl = ws_kernel; asm volatile("" : "+s"(wsl)); int tidl_ = threadIdx.x; asm volatile("" : "+v"(tidl_)); const int tid = tidl_, lane = tidl_ & 63; (void)tid; (void)lane
#define modbuf ((float*)(wsl + WS_MOD))
#define hbuf ((float*)(wsl + WS_H))
#define ubuf ((bf16*)(wsl + WS_U))
#define obuf ((bf16*)(wsl + WS_O))
#define qkvbuf ((bf16*)(wsl + WS_QKV))
#define hidbuf ((bf16*)(wsl + WS_HID))
#define mla_hcat ((float*)(wsl + WS_C_HCAT))
#define mla_cq ((bf16*)(wsl + WS_C_CQ))
#define mla_ckv ((bf16*)(wsl + WS_C_CKV))
#define mla_kr ((bf16*)(wsl + WS_C_KR))
#define mla_q ((bf16*)(wsl + WS_C_Q))
#define mla_kv ((bf16*)(wsl + WS_C_KV))
#define modl (modbuf + (size_t)L * 4 * MODW)
#define hin ((L == 0) ? args.in[0] : (const float*)hbuf)
#define RUN() (pid >= lo && pid < hi)
#define SEAM() do { if (MK_N_LAUNCHES == 1) { if (pid >= lo && pid + 1 < hi) xcd_barrier(bar); } ++pid; } while (0)
template <int L>
__device__ __forceinline__ void layer_body(const Args& args, LAS unsigned char* lds, const int wave, const int G, const int gw, const int NGW, const int lo, const int hi,
                                           unsigned char* const ws_kernel, const XcdBarrier& bar, int& pid) {
    constexpr int kind = L % 3, slot = L / 3;

        if (RUN() && PH_EN(1)) { PHASE_LOCALS;
            const float* gain = args.in[2] + L * D;
            for (int m = gw; m < M; m += NGW) {
                const int b = m >> 11; const float* mb = modl + (size_t)b * MODW;
                const f32x4* xr = (const f32x4*)(hin + (size_t)m * D) + lane; f32x4 v[8]; float ss = 0.f;
#pragma unroll
                for (int j = 0; j < 8; ++j) { v[j] = xr[64 * j]; ss += (v[j].x * v[j].x + v[j].y * v[j].y) + (v[j].z * v[j].z + v[j].w * v[j].w); }
                const float rstd = 1.0f / sqrtf(wave_sum(ss) * (1.0f / D) + EPS);
#pragma unroll
                for (int j = 0; j < 8; ++j) { const int col = 4 * lane + 256 * j;
                    const f32x4 g4 = *(const f32x4*)(gain + col), sh = *(const f32x4*)(mb + col), sc4 = *(const f32x4*)(mb + D + col);
                    const f32x4 y = (v[j] * rstd * g4) * (sc4 + 1.0f) + sh;
                    v2u o; o.x = pk2(y.x, y.y); o.y = pk2(y.z, y.w); *(v2u*)(ubuf + (size_t)m * D + col) = o; }
            }
        }
        SEAM();

        if constexpr (kind == 0) {
            if (RUN() && PH_EN(2)) { PHASE_LOCALS;
                pg8::Gemm g{ubuf, (const bf16*)(wsl + WS_WA_QKV) + (size_t)slot * NQKV_A * D, M, NQKV_A, D}; pg8::StaticOrder S; S.init(M, NQKV_A, G, (int)blockIdx.x);
                pg8::EpiBf16<0> E{qkvbuf, NQKV_A};
                pg8::gemm_phase<pg8::EpiBf16<0>, pg8::StaticOrder, true, true>(lds, g, S, E);
            }
            SEAM();
            if (RUN() && PH_EN(3)) { PHASE_LOCALS;
                const unsigned wl = (unsigned)(size_t)(lds + wave * 16384);
                const float* rpb = args.in[8] + (size_t)slot * NH * 15 * 31;
                const int vw = ((blockIdx.x & 7) * (G >> 3) + (blockIdx.x >> 3)) * NWAVES + wave;
                for (int unit = ((G & 7) == 0 ? vw : gw); unit < NB * NH * 32 * 4; unit += NGW) {
                    const int cb = unit & 3, r = (unit >> 2) & 31, h = (unit >> 7) & 15, b = unit >> 11;
                    NAMap mp; mp.b = b; mp.r = r; mp.r0 = min(max(r - 4, 0), 24); mp.cb = cb; mp.cs = min(max(16 * cb - 8, 0), 32); mp.rpb_h = rpb + h * 15 * 31;
                    f32x4 acc[8]; float mx, sum;
                    attn16_unit<16, NAMap>(wl, qkvbuf + h * HD, qkvbuf + D + h * HD, qkvbuf + 2 * D + h * HD, NQKV_A, mp, lane, 0.08838834764831845f * LOG2E, acc, mx, sum);
                    const float inv = 1.0f / sum; const int qi = lane & 15, kg = lane >> 4;
                    bf16* op = obuf + (size_t)mp.qtok(qi) * D + h * HD + 4 * kg;
#pragma unroll
                    for (int mt = 0; mt < 8; ++mt) { v2u w; w.x = pk2(acc[mt][0] * inv, acc[mt][1] * inv); w.y = pk2(acc[mt][2] * inv, acc[mt][3] * inv); *(v2u*)(op + 16 * mt) = w; }
                }
            }
            SEAM();
        } else if constexpr (kind == 1) {
            if (RUN() && PH_EN(4)) { PHASE_LOCALS;
                pg8::Gemm g{ubuf, (const bf16*)(wsl + WS_WB_QKV), M, NQKV_B, D}; pg8::StaticOrder S; S.init(M, NQKV_B, G, (int)blockIdx.x);
                pg8::EpiBf16<0> E{qkvbuf, NQKV_B};
                pg8::gemm_phase<pg8::EpiBf16<0>, pg8::StaticOrder, true, true>(lds, g, S, E);
            }
            SEAM();
            if (RUN() && PH_EN(5)) { PHASE_LOCALS;
                const int i0 = 4 * (lane & 15);
                float inv[4];
#pragma unroll
                for (int k = 0; k < 4; ++k) inv[k] = rope_inv(i0 + k, 64);
                for (int task = gw; task < M * 3; task += NGW) {
                    const int tok = task / 3, g = task - tok * 3, s = tok & 2047;
                    float cs[4], sn[4];
#pragma unroll
                    for (int k = 0; k < 4; ++k) sincos_rev((float)s * inv[k], sn[k], cs[k]);
                    bf16* base = qkvbuf + (size_t)tok * NQKV_B + g * NQKV_A;
#pragma unroll
                    for (int it = 0; it < 8; ++it) { bf16* p = base + (it * 4 + (lane >> 4)) * HD + i0;
                        const v2u a = *(const v2u*)p, bq = *(const v2u*)(p + 64);
                        const float x1[4] = {bflo(a.x), bfhi(a.x), bflo(a.y), bfhi(a.y)}, x2[4] = {bflo(bq.x), bfhi(bq.x), bflo(bq.y), bfhi(bq.y)};
                        float o1[4], o2[4];
#pragma unroll
                        for (int k = 0; k < 4; ++k) { o1[k] = x1[k] * cs[k] - x2[k] * sn[k]; o2[k] = x2[k] * cs[k] + x1[k] * sn[k]; }
                        v2u wa, wb; wa.x = pk2(o1[0], o1[1]); wa.y = pk2(o1[2], o1[3]); wb.x = pk2(o2[0], o2[1]); wb.y = pk2(o2[2], o2[3]);
                        *(v2u*)p = wa; *(v2u*)(p + 64) = wb; }
                }
            }
            SEAM();
            if (RUN() && PH_EN(6)) { PHASE_LOCALS;
                const unsigned wl = (unsigned)(size_t)(lds + wave * 16384);
                bf16* opart = (bf16*)(wsl + WS_HID); float* lsebuf = (float*)(wsl + WS_HID + 96 * MiB);
                const int vw = ((blockIdx.x & 7) * (G >> 3) + (blockIdx.x >> 3)) * NWAVES + wave;
                for (int unit = ((G & 7) == 0 ? vw : gw); unit < NB * NH * 3 * 128; unit += NGW) {
                    const int idx = unit & 127, bhg = unit >> 7, g = bhg % 3, bh = bhg / 3, h = bh & 15, b = bh >> 4;
                    const int dil = (g == 0) ? 1 : (g == 1 ? 4 : 16), Lc = SEQ / dil, nb = Lc >> 4;
                    DSWMap mp; mp.b = b; mp.dil = dil; mp.rho = idx / nb; mp.m0 = 16 * (idx % nb); mp.Lc = Lc;
                    f32x4 acc[8]; float mx, sum;
                    const bf16* base = qkvbuf + g * NQKV_A + h * HD;
                    attn16_unit<10, DSWMap>(wl, base, base + D, base + 2 * D, NQKV_B, mp, lane, 0.08838834764831845f * LOG2E, acc, mx, sum);
                    const float inv = 1.0f / sum; const int qi = lane & 15, kg = lane >> 4; const int tq = mp.qtok(qi);
                    bf16* op = opart + ((size_t)g * M + tq) * D + h * HD + 4 * kg;
#pragma unroll
                    for (int mt = 0; mt < 8; ++mt) { v2u w; w.x = pk2(acc[mt][0] * inv, acc[mt][1] * inv); w.y = pk2(acc[mt][2] * inv, acc[mt][3] * inv); *(v2u*)(op + 16 * mt) = w; }
                    if (kg == 0) lsebuf[((size_t)g * M + tq) * NH + h] = mx + __log2f(sum);
                }
            }
            SEAM();
            if (RUN() && PH_EN(17)) { PHASE_LOCALS;
                const bf16* opart = (const bf16*)(wsl + WS_HID); const float* lsebuf = (const float*)(wsl + WS_HID + 96 * MiB);
                for (int m = gw; m < M; m += NGW) {
#pragma unroll
                    for (int it = 0; it < 4; ++it) { const int e0 = 8 * (lane + 64 * it), h = e0 >> 7;
                        const float l0 = lsebuf[((size_t)0 * M + m) * NH + h], l1 = lsebuf[((size_t)1 * M + m) * NH + h], l2 = lsebuf[((size_t)2 * M + m) * NH + h];
                        const float lm = fmaxf(l0, fmaxf(l1, l2)); float w0 = __builtin_amdgcn_exp2f(l0 - lm), w1 = __builtin_amdgcn_exp2f(l1 - lm), w2 = __builtin_amdgcn_exp2f(l2 - lm);
                        const float wi = 1.0f / (w0 + w1 + w2); w0 *= wi; w1 *= wi; w2 *= wi;
                        const v4u a = *(const v4u*)(opart + ((size_t)0 * M + m) * D + e0), bq = *(const v4u*)(opart + ((size_t)1 * M + m) * D + e0), cq2 = *(const v4u*)(opart + ((size_t)2 * M + m) * D + e0);
                        v4u o; o.x = pk2(w0 * bflo(a.x) + w1 * bflo(bq.x) + w2 * bflo(cq2.x), w0 * bfhi(a.x) + w1 * bfhi(bq.x) + w2 * bfhi(cq2.x));
                        o.y = pk2(w0 * bflo(a.y) + w1 * bflo(bq.y) + w2 * bflo(cq2.y), w0 * bfhi(a.y) + w1 * bfhi(bq.y) + w2 * bfhi(cq2.y));
                        o.z = pk2(w0 * bflo(a.z) + w1 * bflo(bq.z) + w2 * bflo(cq2.z), w0 * bfhi(a.z) + w1 * bfhi(bq.z) + w2 * bfhi(cq2.z));
                        o.w = pk2(w0 * bflo(a.w) + w1 * bflo(bq.w) + w2 * bflo(cq2.w), w0 * bfhi(a.w) + w1 * bfhi(bq.w) + w2 * bfhi(cq2.w));
                        *(v4u*)(obuf + (size_t)m * D + e0) = o; }
                }
            }
            SEAM();
        } else {
            if (RUN() && PH_EN(7)) { PHASE_LOCALS;
                pg8::Gemm g{ubuf, (const bf16*)(wsl + WS_WC_IN), M, MLA_IN_PAD, D}; pg8::StaticOrder S; S.init(M, MLA_IN_PAD, G, (int)blockIdx.x);
                pg8::EpiF32 E{mla_hcat, MLA_IN_PAD};
                pg8::gemm_phase<pg8::EpiF32, pg8::StaticOrder, true, true>(lds, g, S, E);
            }
            SEAM();
            if (RUN() && PH_EN(8)) { PHASE_LOCALS;
                const float* qn = args.in[12]; const float* kn = args.in[13];
                const float kinv = rope_inv(lane & 31, 32);
                for (int m = gw; m < M; m += NGW) {
                    const float* hr = mla_hcat + (size_t)m * MLA_IN_PAD; const int s = m & 2047;
#pragma unroll
                    for (int part = 0; part < 2; ++part) {
                        const float* src = hr + part * 512 + 8 * lane; const float* gn = (part == 0 ? qn : kn) + 8 * lane;
                        const f32x4 a = *(const f32x4*)src, b4 = *(const f32x4*)(src + 4);
                        const float ss = wave_sum((a.x * a.x + a.y * a.y) + (a.z * a.z + a.w * a.w) + (b4.x * b4.x + b4.y * b4.y) + (b4.z * b4.z + b4.w * b4.w));
                        const float rstd = 1.0f / sqrtf(ss * (1.0f / 512.0f) + EPS);
                        const f32x4 g0 = *(const f32x4*)gn, g1 = *(const f32x4*)(gn + 4);
                        v4u o; o.x = pk2(a.x * rstd * g0.x, a.y * rstd * g0.y); o.y = pk2(a.z * rstd * g0.z, a.w * rstd * g0.w);
                        o.z = pk2(b4.x * rstd * g1.x, b4.y * rstd * g1.y); o.w = pk2(b4.z * rstd * g1.z, b4.w * rstd * g1.w);
                        *(v4u*)((part == 0 ? mla_cq : mla_ckv) + (size_t)m * 512 + 8 * lane) = o;
                    }
                    { const int i = lane & 31; const float x1 = hr[1024 + i], x2 = hr[1024 + 32 + i]; float sn, cs; sincos_rev((float)s * kinv, sn, cs);
                      const float o = (lane < 32) ? (x1 * cs - x2 * sn) : (x2 * cs + x1 * sn);
                      mla_kr[(size_t)m * 64 + lane] = (bf16)f2bf(o); }
                }
            }
            SEAM();
            if (RUN() && PH_EN(9)) { PHASE_LOCALS;
                { pg8::Gemm g{mla_cq, (const bf16*)(wsl + WS_WC_UQ), M, MLA_QW, MLA_QR}; pg8::StaticOrder S; S.init(M, MLA_QW, G, (int)blockIdx.x);
                  pg8::EpiBf16<0> E{mla_q, MLA_QW};
                  pg8::gemm_phase<pg8::EpiBf16<0>, pg8::StaticOrder, true, true>(lds, g, S, E); }
                { pg8::Gemm g{mla_ckv, (const bf16*)(wsl + WS_WC_UKV), M, MLA_KVW, MLA_KVR}; pg8::StaticOrder S; S.init(M, MLA_KVW, G, (int)blockIdx.x);
                  pg8::EpiBf16<0> E{mla_kv, MLA_KVW};
                  pg8::gemm_phase<pg8::EpiBf16<0>, pg8::StaticOrder, true, true>(lds, g, S, E); }
            }
            SEAM();
            if (RUN() && PH_EN(10)) { PHASE_LOCALS;
                const float qinv = rope_inv(lane & 31, 32);
                for (int m = gw; m < M; m += NGW) {
                    const int s = m & 2047; float sn, cs; sincos_rev((float)s * qinv, sn, cs);
#pragma unroll
                    for (int it = 0; it < 8; ++it) { const int h = (lane >> 5) + 2 * it; bf16* p = mla_q + (size_t)m * MLA_QW + h * 192 + 128 + (lane & 31);
                        const float x1 = bf1(p[0]), x2 = bf1(p[32]); p[0] = (bf16)f2bf(x1 * cs - x2 * sn); p[32] = (bf16)f2bf(x2 * cs + x1 * sn); }
                }
            }
            SEAM();
            if (RUN() && PH_EN(11)) { PHASE_LOCALS;
                const int vcu = ((G & 7) == 0) ? (int)((blockIdx.x & 7) * (G >> 3) + (blockIdx.x >> 3)) : (int)blockIdx.x;
                for (int unit = vcu; unit < NB * NH * (SEQ / 256); unit += G) {
                    const int qb8 = unit & 7, h = (unit >> 3) & 15, b = unit >> 7;
                    const size_t row0 = (size_t)b * SEQ;
                    int tidu = tid; asm volatile("" : "+v"(tidu));
                    mla::attn_body(mla_q + (row0 + qb8 * 256) * MLA_QW + h * 192, MLA_QW, mla_kv + row0 * MLA_KVW + h * 256, mla_kv + row0 * MLA_KVW + h * 256 + 128, MLA_KVW,
                                   mla_kr + row0 * 64, obuf + (row0 + qb8 * 256) * D + h * HD, D, SEQ, (unsigned)(size_t)lds, tidu);
                }
            }
            SEAM();
        }

        if (RUN() && PH_EN(12)) { PHASE_LOCALS;
            const bf16* Wo = (kind == 0) ? (const bf16*)(wsl + WS_WA_O) + (size_t)slot * D * D : (kind == 1 ? (const bf16*)(wsl + WS_WB_O) : (const bf16*)(wsl + WS_WC_O));
            pg8::Gemm g{obuf, Wo, M, D, D}; pg8::StaticOrder S; S.init(M, D, G, (int)blockIdx.x);
            pg8::EpiGateRes E{hin, hbuf, D, modl + 2 * D, MODW};
            pg8::gemm_phase<pg8::EpiGateRes, pg8::StaticOrder, true, true>(lds, g, S, E);
        }
        SEAM();

        if (RUN() && PH_EN(13)) { PHASE_LOCALS;
            const float* gain = args.in[3] + L * D;
            for (int m = gw; m < M; m += NGW) {
                const int b = m >> 11; const float* mb = modl + (size_t)b * MODW + 3 * D;
                const f32x4* xr = (const f32x4*)(hbuf + (size_t)m * D) + lane; f32x4 v[8]; float ss = 0.f;
#pragma unroll
                for (int j = 0; j < 8; ++j) { v[j] = xr[64 * j]; ss += (v[j].x * v[j].x + v[j].y * v[j].y) + (v[j].z * v[j].z + v[j].w * v[j].w); }
                const float rstd = 1.0f / sqrtf(wave_sum(ss) * (1.0f / D) + EPS);
#pragma unroll
                for (int j = 0; j < 8; ++j) { const int col = 4 * lane + 256 * j;
                    const f32x4 g4 = *(const f32x4*)(gain + col), sh = *(const f32x4*)(mb + col), sc4 = *(const f32x4*)(mb + D + col);
                    const f32x4 y = (v[j] * rstd * g4) * (sc4 + 1.0f) + sh;
                    v2u o; o.x = pk2(y.x, y.y); o.y = pk2(y.z, y.w); *(v2u*)(ubuf + (size_t)m * D + col) = o; }
            }
        }
        SEAM();

        if (RUN() && PH_EN(14)) { PHASE_LOCALS;
            pg8::Gemm g{ubuf, (const bf16*)(wsl + WS_WUP) + (size_t)L * FF * D, M, FF, D}; pg8::StaticOrder S; S.init(M, FF, G, (int)blockIdx.x);
            pg8::EpiBf16<1> E{hidbuf, FF};
            pg8::gemm_phase<pg8::EpiBf16<1>, pg8::StaticOrder, true, true>(lds, g, S, E);
        }
        SEAM();

        if (RUN() && PH_EN(15)) { PHASE_LOCALS;
            pg8::Gemm g{hidbuf, (const bf16*)(wsl + WS_WDN) + (size_t)L * D * FF, M, D, FF}; pg8::StaticOrder S; S.init(M, D, G, (int)blockIdx.x);
            pg8::EpiGateRes E{hbuf, hbuf, D, modl + 5 * D, MODW};
            pg8::gemm_phase<pg8::EpiGateRes, pg8::StaticOrder, true, true>(lds, g, S, E);
        }
        SEAM();
}

__global__ void __launch_bounds__(NWAVES * 64, 2) fwd_kernel(Args args) {
    extern __shared__ __attribute__((aligned(16))) unsigned char lds_raw[];
    LAS unsigned char* lds = (LAS unsigned char*)lds_raw;
    volatile LAS unsigned* MISC = (volatile LAS unsigned*)(lds + MISC_OFF);
    const int tid = threadIdx.x, lane = tid & 63, wave = __builtin_amdgcn_readfirstlane(tid >> 6);
    const int G = gridDim.x;
    const int gw = blockIdx.x * NWAVES + wave, NGW = G * NWAVES;
    unsigned char* const ws_kernel = args.ws;
    for (int u = tid; u < (LDS_BYTES - LDSCTL_OFF) / 4; u += NWAVES * 64) ((LAS unsigned*)(lds + LDSCTL_OFF))[u] = 0u;
    __syncthreads();
    XcdBarrier bar; bar.bar = (unsigned*)(ws_kernel + WS_CTL) + CW_BAR; bar.x = 0; bar.st = nullptr;
    if (MK_N_LAUNCHES == 1) bar = xcd_barrier_post((unsigned*)(ws_kernel + WS_CTL) + CW_BAR, MISC + 8);
    const int lo = args.ph_lo, hi = args.ph_hi;
    int pid = 0;


    if (RUN() && PH_EN(0)) { PHASE_LOCALS;
        {
            LAS float* sc = (LAS float*)lds; LAS float* red = (LAS float*)(lds + 32768);
            const float* cc = args.in[1];
            for (int i = tid; i < NB * D; i += NWAVES * 64) { const float xv = cc[i]; sc[i] = xv / (1.0f + __expf(-xv)); }
            __syncthreads();
            for (int task = blockIdx.x; task < 256; task += G) {
                const int l = task >> 6, cg = task & 63;
                f32x4 acc[4];
#pragma unroll
                for (int b = 0; b < 4; ++b) acc[b] = (f32x4){0.f, 0.f, 0.f, 0.f};
                if (lane < 48) {
                    const float* Wp = args.in[4] + ((size_t)l * D + (size_t)wave * 256) * MODW + cg * 192 + 4 * lane;
                    for (int d = 0; d < 256; d += 8) {
                        f32x4 w[8];
#pragma unroll
                        for (int j = 0; j < 8; ++j) w[j] = *(const f32x4*)(Wp + (size_t)(d + j) * MODW);
#pragma unroll
                        for (int j = 0; j < 8; ++j)
#pragma unroll
                            for (int b = 0; b < 4; ++b) acc[b] += sc[b * D + wave * 256 + d + j] * w[j];
                    }
#pragma unroll
                    for (int b = 0; b < 4; ++b) *(LAS f32x4*)(red + (wave * 4 + b) * 192 + 4 * lane) = acc[b];
                }
                __syncthreads();
                for (int i = tid; i < 4 * 192; i += NWAVES * 64) { const int b = i / 192, c2 = i % 192; float s = args.in[5][l * MODW + cg * 192 + c2];
#pragma unroll
                    for (int w = 0; w < 8; ++w) s += red[(w * 4 + b) * 192 + c2];
                    modbuf[(size_t)(l * 4 + b) * MODW + cg * 192 + c2] = s; }
                __syncthreads();
            }
        }
        {
            LAS float* scr = (LAS float*)(lds + wave * 16384);
            constexpr int I_AQ = (D / 64) * (NQKV_A / 32), I_DD = (D / 64) * (D / 32), I_BQ = (D / 64) * (NQKV_B / 32), I_CIN = (D / 64) * (MLA_IN / 32),
                          I_UQ = (MLA_QR / 64) * (MLA_QW / 32), I_UKV = (MLA_KVR / 64) * (MLA_KVW / 32), I_UP = (D / 64) * (FF / 32), I_DN = (FF / 64) * (D / 32);
            constexpr int NITEMS = 2 * I_AQ + 2 * I_DD + I_BQ + I_DD + I_CIN + I_UQ + I_UKV + I_DD + 4 * I_UP + 4 * I_DN;
            for (int it = gw; it < NITEMS; it += NGW) {
                int r = it; const float* W; int K, N; bf16* WT;
                if (r < 2 * I_AQ) { const int s = r / I_AQ; r -= s * I_AQ; W = args.in[6] + (size_t)s * D * NQKV_A; K = D; N = NQKV_A; WT = (bf16*)(wsl + WS_WA_QKV) + (size_t)s * NQKV_A * D; }
                else if ((r -= 2 * I_AQ) < 2 * I_DD) { const int s = r / I_DD; r -= s * I_DD; W = args.in[7] + (size_t)s * D * D; K = D; N = D; WT = (bf16*)(wsl + WS_WA_O) + (size_t)s * D * D; }
                else if ((r -= 2 * I_DD) < I_BQ) { W = args.in[9]; K = D; N = NQKV_B; WT = (bf16*)(wsl + WS_WB_QKV); }
                else if ((r -= I_BQ) < I_DD) { W = args.in[10]; K = D; N = D; WT = (bf16*)(wsl + WS_WB_O); }
                else if ((r -= I_DD) < I_CIN) { W = args.in[11]; K = D; N = MLA_IN; WT = (bf16*)(wsl + WS_WC_IN); }
                else if ((r -= I_CIN) < I_UQ) { W = args.in[14]; K = MLA_QR; N = MLA_QW; WT = (bf16*)(wsl + WS_WC_UQ); }
                else if ((r -= I_UQ) < I_UKV) { W = args.in[15]; K = MLA_KVR; N = MLA_KVW; WT = (bf16*)(wsl + WS_WC_UKV); }
                else if ((r -= I_UKV) < I_DD) { W = args.in[16]; K = D; N = D; WT = (bf16*)(wsl + WS_WC_O); }
                else if ((r -= I_DD) < 4 * I_UP) { const int s = r / I_UP; r -= s * I_UP; W = args.in[17] + (size_t)s * D * FF; K = D; N = FF; WT = (bf16*)(wsl + WS_WUP) + (size_t)s * FF * D; }
                else { r -= 4 * I_UP; const int s = r / I_DN; r -= s * I_DN; W = args.in[18] + (size_t)s * FF * D; K = FF; N = D; WT = (bf16*)(wsl + WS_WDN) + (size_t)s * D * FF; }
                p0_transpose_item(W, K, N, WT, scr, r, lane);
            }
            { v4u* z = (v4u*)((bf16*)(wsl + WS_WC_IN) + (size_t)MLA_IN * D); const int nz = (MLA_IN_PAD - MLA_IN) * D / 8;
              for (int i = blockIdx.x * (NWAVES * 64) + tid; i < nz; i += G * NWAVES * 64) z[i] = (v4u){0u, 0u, 0u, 0u}; }
        }
    }
    SEAM();

    layer_body<0>(args, lds, wave, G, gw, NGW, lo, hi, ws_kernel, bar, pid);
    layer_body<1>(args, lds, wave, G, gw, NGW, lo, hi, ws_kernel, bar, pid);
    layer_body<2>(args, lds, wave, G, gw, NGW, lo, hi, ws_kernel, bar, pid);
    layer_body<3>(args, lds, wave, G, gw, NGW, lo, hi, ws_kernel, bar, pid);

    if (RUN() && PH_EN(16)) { PHASE_LOCALS;
        const float* gain = args.in[19];
        for (int m = gw; m < M; m += NGW) {
            const f32x4* xr = (const f32x4*)(hbuf + (size_t)m * D) + lane; f32x4 v[8]; float ss = 0.f;
#pragma unroll
            for (int j = 0; j < 8; ++j) { v[j] = xr[64 * j]; ss += (v[j].x * v[j].x + v[j].y * v[j].y) + (v[j].z * v[j].z + v[j].w * v[j].w); }
            const float rstd = 1.0f / sqrtf(wave_sum(ss) * (1.0f / D) + EPS);
#pragma unroll
            for (int j = 0; j < 8; ++j) { const int col = 4 * lane + 256 * j; const f32x4 g4 = *(const f32x4*)(gain + col);
                *(f32x4*)(args.out + (size_t)m * D + col) = v[j] * rstd * g4; }
        }
    }
    ++pid;
}

constexpr int NPH_MAX = 48;

extern "C" void kernel_launch(void* const* d_in, const int* in_sizes, int n_in, void* d_out, int out_size, void* d_ws, size_t ws_size, hipStream_t stream) {
    static int grid = 0;
    if (grid == 0) {
        if (n_in != 20 || out_size != M * D || ws_size < WS_END) { fprintf(stderr, "kernel_launch: unexpected shapes (n_in %d out %d ws %zu); nothing launched\n", n_in, out_size, ws_size); grid = -1; return; }
        int dev = 0, cus = 0, per_cu = 0;
        if (hipGetDevice(&dev) != hipSuccess || hipDeviceGetAttribute(&cus, hipDeviceAttributeMultiprocessorCount, dev) != hipSuccess) { grid = -1; return; }
        if (hipFuncSetAttribute((const void*)fwd_kernel, hipFuncAttributeMaxDynamicSharedMemorySize, LDS_BYTES) != hipSuccess) { fprintf(stderr, "kernel_launch: hipFuncSetAttribute failed\n"); grid = -1; return; }
        if (hipOccupancyMaxActiveBlocksPerMultiprocessor(&per_cu, (const void*)fwd_kernel, NWAVES * 64, LDS_BYTES) != hipSuccess || per_cu < 1)
            fprintf(stderr, "kernel_launch: note: occupancy query reports %d workgroups per CU\n", per_cu);
        (void)hipGetLastError();
        grid = cus;
    }
    if (grid < 0) return;
    if (hipMemsetAsync((char*)d_ws + WS_CTL, 0, CTL_ZERO_BYTES, stream) != hipSuccess) return;
    Args a{};
    for (int i = 0; i < 20; ++i) a.in[i] = (const float*)d_in[i];
    a.out = (float*)d_out; a.ws = (unsigned char*)d_ws;
#if MK_N_LAUNCHES == 1
    a.ph_lo = 0; a.ph_hi = 1 << 20;
    hipLaunchKernelGGL(fwd_kernel, dim3(grid), dim3(NWAVES * 64), LDS_BYTES, stream, a);
#else
    for (int p = 0; p < NPH_MAX; ++p) { a.ph_lo = p; a.ph_hi = p + 1; hipLaunchKernelGGL(fwd_kernel, dim3(grid), dim3(NWAVES * 64), LDS_BYTES, stream, a); }
#endif
    const hipError_t le = hipPeekAtLastError();
    if (le != hipSuccess) fprintf(stderr, "kernel_launch: launch failed: %s\n", hipGetErrorName(le));
}
```
